# Optimizing an MI355X kernel written in HIP

```python
import math
import jax, jax.numpy as jnp
from jax import lax
import numpy as np

D_MODEL = 1024
BATCH = 16
SEQ = 2048
DEPTH = 2

GRID_W = 64
CTX_LEN = 256
N_MOD = 9
FFN_HIDDEN = 2816
LN_EPS = 1e-5
RMS_EPS = 1e-6
DEEPNORM_ALPHA = (2 * DEPTH) ** 0.25
DEEPNORM_BETA = (8 * DEPTH) ** -0.25
MIX_WIDTH = 1024

RWKV_HEADS = 8
RWKV_HEAD_DIM = 64
RWKV_WIDTH = RWKV_HEADS * RWKV_HEAD_DIM
RWKV_DECAY_LORA = 64
RWKV_AAA_LORA = 64
RWKV_GATE_LORA = 128
RWKV_GN_EPS = 64e-5
NA_HEADS = 8
NA_HEAD_DIM = 64
NA_WIDTH = NA_HEADS * NA_HEAD_DIM
NA_WIN_R = 8
NA_WIN_C = 16
GLA_HEADS = 4
GLA_DK = 64
GLA_DV = 128
GLA_GATE_LORA = 16
GLA_GATE_NORM = 16.0
GLA_CHUNK = 64
DIFF_HEADS = 4
DIFF_DH = 64
DIFF_DV = 128
Q_BLOCK = 128
ROPE_BASE = 10000.0

RWKV_COLS = (RWKV_WIDTH, RWKV_WIDTH, RWKV_WIDTH, RWKV_DECAY_LORA, RWKV_DECAY_LORA, RWKV_AAA_LORA, RWKV_AAA_LORA, RWKV_GATE_LORA)
NA_COLS = (NA_WIDTH, NA_WIDTH, NA_WIDTH)
GLA_COLS = (GLA_HEADS * GLA_DK, GLA_HEADS * GLA_DK, GLA_HEADS * GLA_DV, GLA_HEADS * GLA_DV, GLA_GATE_LORA, GLA_GATE_LORA)
DIFF_COLS = (DIFF_HEADS * 2 * DIFF_DH, DIFF_HEADS * 2 * DIFF_DH, DIFF_HEADS * DIFF_DV)
IN_COLS_EVEN = sum(RWKV_COLS) + sum(NA_COLS)
IN_COLS_ODD = sum(GLA_COLS) + sum(DIFF_COLS)

kernel_name = 'hybrid_rwkv7_natten_gla_diffattn_dit'


def split_cols(u, sizes):
    out, o = [], 0
    for s in sizes:
        out.append(u[..., o:o + s])
        o += s
    return out


def layer_norm(x, g, b):
    xf = x.astype(jnp.float32)
    mu = jnp.mean(xf, -1, keepdims=True)
    var = jnp.mean(jnp.square(xf - mu), -1, keepdims=True)
    return ((xf - mu) * lax.rsqrt(var + LN_EPS) * g + b).astype(x.dtype)


def head_rms_norm(x, g):
    xf = x.astype(jnp.float32)
    return (xf * lax.rsqrt(jnp.mean(xf * xf, -1, keepdims=True) + RMS_EPS) * g).astype(x.dtype)


def to_heads(t, n_heads):
    b, l, _ = t.shape
    return t.reshape(b, l, n_heads, -1).transpose(0, 2, 1, 3)


def from_heads(t):
    b, h, l, d = t.shape
    return t.transpose(0, 2, 1, 3).reshape(b, l, h * d)


def modulate(x, shift, scale):
    return x * (1 + scale) + shift


def post_norm(x, y, gate, g, b):
    return layer_norm(DEEPNORM_ALPHA * x + gate * y, g, b)


def swiglu(h, w_gu, w_down):
    gate, up = jnp.split(h @ w_gu, 2, axis=-1)
    return (jax.nn.silu(gate) * up) @ w_down


def half_ffn_update(x, mods, w_gu, w_down, g, b):
    shift, scale, gate = mods
    return post_norm(x, 0.5 * swiglu(modulate(x, shift, scale), w_gu, w_down), gate, g, b)


def _rotate(x, pos):
    n = x.shape[-1] // 2
    freqs = ROPE_BASE ** (-jnp.arange(n, dtype=jnp.float32) / n)
    ang = pos.astype(jnp.float32)[:, None] * freqs[None, :]
    cos = jnp.cos(ang).astype(x.dtype)
    sin = jnp.sin(ang).astype(x.dtype)
    x1, x2 = x[..., :n], x[..., n:]
    return jnp.concatenate([x1 * cos - x2 * sin, x2 * cos + x1 * sin], axis=-1)


def axial_rope(t, pos_row, pos_col):
    half = t.shape[-1] // 2
    return jnp.concatenate([_rotate(t[..., :half], pos_row), _rotate(t[..., half:], pos_col)], axis=-1)


def centred_token_shift(u, mu):
    prev = jnp.pad(u[:, :-1], ((0, 0), (1, 0), (0, 0)))
    nxt = jnp.pad(u[:, 1:], ((0, 0), (0, 1), (0, 0)))
    return u + mu * (0.5 * (prev + nxt) - u)


def rwkv7_inputs(u, mu, w0, w2, a0, a2, k_k, k_a):
    f32 = jnp.float32
    u = centred_token_shift(u, mu)
    r, k, v, wd_f, wd_b, ad_f, ad_b, gd = split_cols(u, RWKV_COLS)
    b_, t_, _ = u.shape
    heads = lambda z: z.astype(f32).reshape(b_, t_, RWKV_HEADS, RWKV_HEAD_DIM)

    def decay(wd, w0_d, w2_d):
        wl = (w0_d + jnp.tanh(wd) @ w2_d).astype(f32)
        return jnp.exp(-jnp.exp(-jax.nn.softplus(-wl) - 0.5))

    def iclr(ad, a0_d, a2_d):
        return jax.nn.sigmoid((a0_d + ad @ a2_d).astype(f32))

    a_f, a_b = iclr(ad_f, a0[0], a2[0]), iclr(ad_b, a0[1], a2[1])
    kf = k.astype(f32)
    kk = heads(kf * k_k)
    kk = kk / jnp.maximum(jnp.sqrt(jnp.sum(kk * kk, -1, keepdims=True)), 1e-12)
    return dict(r=heads(r), k=heads(k), v=heads(v), kk=kk,
                w_f=heads(decay(wd_f, w0[0], w2[0])), w_b=heads(decay(wd_b, w0[1], w2[1])),
                k_f=heads(kf * (1 + (a_f - 1) * k_a)), k_b=heads(kf * (1 + (a_b - 1) * k_a)),
                a_f=heads(a_f), a_b=heads(a_b), gd=gd)


def rwkv7_scan(state, r, w, k, v, kk, a, reverse, emit):
    def step(S, inp):
        r_t, w_t, k_t, v_t, kk_t, a_t = inp
        s_kk = jnp.einsum('bhvk,bhk->bhv', S, kk_t)
        S = S * w_t[:, :, None, :] - s_kk[..., None] * (kk_t * a_t)[:, :, None, :] + v_t[..., None] * k_t[:, :, None, :]
        if not emit:
            return S, None
        return S, jnp.einsum('bhvk,bhk->bhv', S, r_t)
    xs = tuple(jnp.moveaxis(t, 1, 0) for t in (r, w, k, v, kk, a))
    S, y = lax.scan(step, state, xs, reverse=reverse)
    return S, (jnp.moveaxis(y, 0, 1) if emit else None)


def rwkv7_output(y, d, g2, gn_g, gn_b, r_k, out_dtype):
    b_, t_ = y.shape[:2]
    mu = jnp.mean(y, -1, keepdims=True)
    var = jnp.mean(jnp.square(y - mu), -1, keepdims=True)
    yn = ((y - mu) * lax.rsqrt(var + RWKV_GN_EPS)).reshape(b_, t_, RWKV_WIDTH) * gn_g + gn_b
    bonus = (jnp.sum(d['r'] * d['k'] * r_k, -1, keepdims=True) * d['v']).reshape(b_, t_, RWKV_WIDTH)
    g = jax.nn.sigmoid(d['gd']) @ g2
    return ((yn + bonus) * g).astype(out_dtype)


def rwkv7_mix(u, uc, mu, w0, w2, a0, a2, g2, k_k, k_a, r_k, gn_g, gn_b, need_ctx):
    lat = rwkv7_inputs(u, mu, w0, w2, a0, a2, k_k, k_a)
    cx = rwkv7_inputs(uc, mu, w0, w2, a0, a2, k_k, k_a)
    S0 = jnp.zeros((u.shape[0], RWKV_HEADS, RWKV_HEAD_DIM, RWKV_HEAD_DIM), jnp.float32)

    def run(d, S, dr, reverse, emit):
        return rwkv7_scan(S, d['r'], d['w_' + dr], d['k_' + dr], d['v'], d['kk'], d['a_' + dr], reverse, emit)

    S_f, yc_f = run(cx, S0, 'f', False, need_ctx)
    S_b, yc_b = run(cx, S0, 'b', True, need_ctx)
    _, y_f = run(lat, S_f, 'f', False, True)
    _, y_b = run(lat, S_b, 'b', True, True)
    y = rwkv7_output(y_f + y_b, lat, g2, gn_g, gn_b, r_k, u.dtype)
    yc = rwkv7_output(yc_f + yc_b, cx, g2, gn_g, gn_b, r_k, uc.dtype) if need_ctx else None
    return y, yc


def dense_ctx_attention(q, k, v):
    p = jax.nn.softmax(jnp.einsum('bhqd,bhkd->bhqk', q, k).astype(jnp.float32), -1).astype(v.dtype)
    return jnp.einsum('bhqk,bhkd->bhqd', p, v)


def neighbourhood_attention(q, k, v, qc, kc, vc, rpb, need_ctx):
    b_, s_, _ = q.shape
    rows = s_ // GRID_W
    wr, wc = min(NA_WIN_R, rows), NA_WIN_C
    H, dh = NA_HEADS, NA_HEAD_DIM
    scale = dh ** -0.5
    grid = lambda t: t.reshape(b_, rows, GRID_W, H, dh).transpose(0, 3, 1, 2, 4)
    qg, kg, vg = grid(q * scale), grid(k), grid(v)
    kch, vch = to_heads(kc, H), to_heads(vc, H)
    cols = jnp.arange(GRID_W)
    col_start = jnp.clip(cols - wc // 2, 0, GRID_W - wc)
    col_in = (cols[None, :] >= col_start[:, None]) & (cols[None, :] < col_start[:, None] + wc)
    dc_idx = jnp.clip(cols[None, :] - cols[:, None] + NA_WIN_C - 1, 0, 2 * NA_WIN_C - 2)
    rpb_cols = rpb[:, :, dc_idx]

    def one_row(args):
        r, q_r = args
        rs = jnp.clip(r - wr // 2, 0, rows - wr)
        k_band = lax.dynamic_slice_in_dim(kg, rs, wr, axis=2)
        v_band = lax.dynamic_slice_in_dim(vg, rs, wr, axis=2)
        dr_idx = rs + jnp.arange(wr) - r + NA_WIN_R - 1
        bias = jnp.take(rpb_cols, dr_idx, axis=1).transpose(0, 2, 1, 3)
        s_loc = jnp.einsum('bhqd,bhikd->bhqik', q_r, k_band).astype(jnp.float32) + bias[None]
        s_loc = jnp.where(col_in[:, None, :], s_loc, -jnp.inf).reshape(b_, H, GRID_W, wr * GRID_W)
        s_ctx = jnp.einsum('bhqd,bhld->bhql', q_r, kch).astype(jnp.float32)
        p = jax.nn.softmax(jnp.concatenate([s_loc, s_ctx], -1), -1).astype(v.dtype)
        p_loc = p[..., :wr * GRID_W].reshape(b_, H, GRID_W, wr, GRID_W)
        p_ctx = p[..., wr * GRID_W:]
        return jnp.einsum('bhqik,bhikd->bhqd', p_loc, v_band) + jnp.einsum('bhql,bhld->bhqd', p_ctx, vch)

    out = lax.map(one_row, (jnp.arange(rows), jnp.moveaxis(qg, 2, 0)))
    y = out.transpose(1, 0, 3, 2, 4).reshape(b_, s_, H * dh)
    yc = from_heads(dense_ctx_attention(to_heads(qc * scale, H), kch, vch)) if need_ctx else None
    return y, yc


def rwkv_na_mixer(h, hc, w_in, w_out, mu, w0, w2, a0, a2, g2, k_k, k_a, r_k, gn_g, gn_b, rpb, need_ctx):
    u, uc = h @ w_in, hc @ w_in
    n_a = sum(RWKV_COLS)
    y_a, yc_a = rwkv7_mix(u[..., :n_a], uc[..., :n_a], mu, w0, w2, a0, a2, g2, k_k, k_a, r_k, gn_g, gn_b, need_ctx)
    q, k, v = split_cols(u[..., n_a:], NA_COLS)
    qc, kc, vc = split_cols(uc[..., n_a:], NA_COLS)
    y_b, yc_b = neighbourhood_attention(q, k, v, qc, kc, vc, rpb, need_ctx)
    y = jnp.concatenate([y_a, y_b], -1) @ w_out
    yc = jnp.concatenate([yc_a, yc_b], -1) @ w_out if need_ctx else None
    return y, yc


def gla_chunk_scan(state, q, k, v, g, emit):
    b_, h_, t_, _ = q.shape
    n = t_ // GLA_CHUNK
    chunk = lambda t: t.reshape(b_, h_, n, GLA_CHUNK, t.shape[-1]).transpose(2, 0, 1, 3, 4)
    tri = jnp.tril(jnp.ones((GLA_CHUNK, GLA_CHUNK), bool))

    def step(S, inp):
        q_c, k_c, v_c, g_c = inp
        bcum = jnp.cumsum(g_c, axis=2)
        b_last = bcum[:, :, -1:, :]
        S_new = jnp.exp(b_last[:, :, 0, :, None]) * S + jnp.einsum('bhsk,bhsv->bhkv', k_c * jnp.exp(b_last - bcum), v_c)
        if not emit:
            return S_new, None
        o_inter = jnp.einsum('bhtk,bhkv->bhtv', q_c * jnp.exp(bcum), S)
        dec = jnp.exp(jnp.where(tri[:, :, None], bcum[:, :, :, None, :] - bcum[:, :, None, :, :], -jnp.inf))
        a_ts = jnp.einsum('bhtk,bhsk,bhtsk->bhts', q_c, k_c, dec)
        return S_new, o_inter + jnp.einsum('bhts,bhsv->bhtv', a_ts, v_c)

    S, o = lax.scan(step, state, tuple(chunk(t) for t in (q, k, v, g)))
    return S, (o.transpose(1, 2, 0, 3, 4).reshape(b_, h_, t_, -1) if emit else None)


def gla_mix(u, uc, g2, gb, norm_g, need_ctx):
    f32 = jnp.float32

    def prep(z):
        q, k, v, r, gd_f, gd_b = split_cols(z, GLA_COLS)
        heads = lambda t: to_heads(t.astype(f32), GLA_HEADS)
        gate = lambda gd, d: heads(jax.nn.log_sigmoid((gd @ g2[d] + gb[d]).astype(f32)) / GLA_GATE_NORM)
        return dict(q=heads(q) * GLA_DK ** -0.5, k=heads(k), v=heads(v), g_f=gate(gd_f, 0), g_b=gate(gd_b, 1), r=r)

    lat, cx = prep(u), prep(uc)
    S0 = jnp.zeros((u.shape[0], GLA_HEADS, GLA_DK, GLA_DV), f32)
    flip = lambda t: jnp.flip(t, axis=2)

    def run(d, S, dr, emit):
        if dr == 'f':
            return gla_chunk_scan(S, d['q'], d['k'], d['v'], d['g_f'], emit)
        S, o = gla_chunk_scan(S, flip(d['q']), flip(d['k']), flip(d['v']), flip(d['g_b']), emit)
        return S, (flip(o) if emit else None)

    def finish(o, r):
        return from_heads(head_rms_norm(o, norm_g)).astype(r.dtype) * jax.nn.silu(r)

    S_f, oc_f = run(cx, S0, 'f', need_ctx)
    S_b, oc_b = run(cx, S0, 'b', need_ctx)
    _, o_f = run(lat, S_f, 'f', True)
    _, o_b = run(lat, S_b, 'b', True)
    y = finish(o_f + o_b, lat['r'])
    yc = finish(oc_f + oc_b, cx['r']) if need_ctx else None
    return y, yc


def diff_attention(q, k, v, qc, kc, vc, lam_params, norm_g, lambda_init, need_ctx):
    b_, s_, _ = q.shape
    H = DIFF_HEADS
    scale = DIFF_DH ** -0.5
    pos = jnp.arange(s_)
    pos_r, pos_c = pos // GRID_W, pos % GRID_W
    pair = lambda t: t.reshape(t.shape[0], t.shape[1], H, 2, DIFF_DH).transpose(0, 2, 3, 1, 4)
    qh = axial_rope(pair(q), pos_r, pos_c) * scale
    kh = axial_rope(pair(k), pos_r, pos_c)
    vh = to_heads(v, H)
    kch, vch = pair(kc), to_heads(vc, H)
    lp = lam_params.astype(jnp.float32)
    lam = jnp.exp(jnp.sum(lp[0] * lp[1])) - jnp.exp(jnp.sum(lp[2] * lp[3])) + lambda_init

    def attend(q_blk, k_, v_):
        p = jax.nn.softmax(jnp.einsum('bhmqd,bhmkd->bhmqk', q_blk, k_).astype(jnp.float32), -1)
        a = p[:, :, 0] - lam * p[:, :, 1]
        return jnp.einsum('bhqk,bhkv->bhqv', a.astype(v_.dtype), v_)

    def finish(o):
        return from_heads(head_rms_norm(o, norm_g) * (1 - lambda_init))

    k_all = jnp.concatenate([kh, kch], axis=3)
    v_all = jnp.concatenate([vh, vch], axis=2)
    nb = s_ // Q_BLOCK
    q_blocks = qh.reshape(b_, H, 2, nb, Q_BLOCK, DIFF_DH).transpose(3, 0, 1, 2, 4, 5)
    o = lax.map(lambda qb: attend(qb, k_all, v_all), q_blocks)
    y = finish(o.transpose(1, 2, 0, 3, 4).reshape(b_, H, s_, DIFF_DV))
    yc = finish(attend(pair(qc) * scale, kch, vch)) if need_ctx else None
    return y, yc


def gla_diff_mixer(h, hc, w_in, w_out, gla_g2, gla_gb, gla_norm_g, diff_lambda, diff_norm_g, lambda_init, need_ctx):
    u, uc = h @ w_in, hc @ w_in
    n_c = sum(GLA_COLS)
    y_c, yc_c = gla_mix(u[..., :n_c], uc[..., :n_c], gla_g2, gla_gb, gla_norm_g, need_ctx)
    q, k, v = split_cols(u[..., n_c:], DIFF_COLS)
    qc, kc, vc = split_cols(uc[..., n_c:], DIFF_COLS)
    y_d, yc_d = diff_attention(q, k, v, qc, kc, vc, diff_lambda, diff_norm_g, lambda_init, need_ctx)
    y = jnp.concatenate([y_c, y_d], -1) @ w_out
    yc = jnp.concatenate([yc_c, yc_d], -1) @ w_out if need_ctx else None
    return y, yc


def setup_inputs(seed: int = 0) -> dict:
    key = jax.random.key(seed)
    ks = iter(jax.random.split(key, 64))
    nrm = lambda shape, s: jax.random.normal(next(ks), shape, jnp.float32) * s
    D = D_MODEL
    inp = {}
    inp['x'] = nrm((BATCH, SEQ, D), 1.0)
    inp['c'] = nrm((BATCH, D), 1.0)
    inp['ctx'] = nrm((BATCH, CTX_LEN, D), 1.0)
    inp['c_ctx'] = nrm((D,), 1.0)
    for l in range(DEPTH):
        inp[f'w_mod_{l}'] = nrm((D, N_MOD * D), 0.5 * D ** -0.5)
        inp[f'b_mod_{l}'] = nrm((N_MOD * D,), 0.02)
        inp[f'ln_g_{l}'] = 1.0 + nrm((3, D), 0.02)
        inp[f'ln_b_{l}'] = nrm((3, D), 0.02)
        inp[f'ffn_gu_{l}'] = nrm((2, D, 2 * FFN_HIDDEN), D ** -0.5)
        inp[f'ffn_down_{l}'] = nrm((2, FFN_HIDDEN, D), FFN_HIDDEN ** -0.5 * DEEPNORM_BETA)
        inp[f'w_in_{l}'] = nrm((D, IN_COLS_EVEN if l % 2 == 0 else IN_COLS_ODD), D ** -0.5)
        inp[f'w_out_{l}'] = nrm((MIX_WIDTH, D), MIX_WIDTH ** -0.5 * DEEPNORM_BETA)
        if l % 2 == 0:
            inp[f'rwkv_mu_{l}'] = jax.random.uniform(next(ks), (sum(RWKV_COLS),), jnp.float32)
            inp[f'rwkv_w0_{l}'] = jnp.linspace(-6.5, -1.5, RWKV_WIDTH, dtype=jnp.float32)[None] + nrm((2, RWKV_WIDTH), 0.1)
            inp[f'rwkv_w2_{l}'] = nrm((2, RWKV_DECAY_LORA, RWKV_WIDTH), 0.1 * RWKV_DECAY_LORA ** -0.5)
            inp[f'rwkv_a0_{l}'] = nrm((2, RWKV_WIDTH), 0.1)
            inp[f'rwkv_a2_{l}'] = nrm((2, RWKV_AAA_LORA, RWKV_WIDTH), 0.1 * RWKV_AAA_LORA ** -0.5)
            inp[f'rwkv_g2_{l}'] = nrm((RWKV_GATE_LORA, RWKV_WIDTH), RWKV_GATE_LORA ** -0.5)
            inp[f'rwkv_k_k_{l}'] = 0.85 + nrm((RWKV_WIDTH,), 0.02)
            inp[f'rwkv_k_a_{l}'] = 1.0 + nrm((RWKV_WIDTH,), 0.02)
            inp[f'rwkv_r_k_{l}'] = nrm((RWKV_HEADS, RWKV_HEAD_DIM), 0.1)
            inp[f'rwkv_gn_g_{l}'] = 1.0 + nrm((RWKV_WIDTH,), 0.02)
            inp[f'rwkv_gn_b_{l}'] = nrm((RWKV_WIDTH,), 0.02)
            inp[f'na_rpb_{l}'] = nrm((NA_HEADS, 2 * NA_WIN_R - 1, 2 * NA_WIN_C - 1), 0.1)
        else:
            inp[f'gla_g2_{l}'] = nrm((2, GLA_GATE_LORA, GLA_HEADS * GLA_DK), GLA_GATE_LORA ** -0.5)
            inp[f'gla_gb_{l}'] = nrm((2, GLA_HEADS * GLA_DK), 0.1)
            inp[f'gla_norm_g_{l}'] = 1.0 + nrm((GLA_DV,), 0.02)
            inp[f'diff_lambda_{l}'] = nrm((4, DIFF_DH), 0.1)
            inp[f'diff_norm_g_{l}'] = 1.0 + nrm((DIFF_DV,), 0.02)
    return inp


def reference(x, c, ctx, c_ctx,
              w_mod_0, b_mod_0, ln_g_0, ln_b_0, ffn_gu_0, ffn_down_0, w_in_0, w_out_0,
              rwkv_mu_0, rwkv_w0_0, rwkv_w2_0, rwkv_a0_0, rwkv_a2_0, rwkv_g2_0, rwkv_k_k_0, rwkv_k_a_0,
              rwkv_r_k_0, rwkv_gn_g_0, rwkv_gn_b_0, na_rpb_0,
              w_mod_1, b_mod_1, ln_g_1, ln_b_1, ffn_gu_1, ffn_down_1, w_in_1, w_out_1,
              gla_g2_1, gla_gb_1, gla_norm_g_1, diff_lambda_1, diff_norm_g_1):
    per_layer = (
        (w_mod_0, b_mod_0, ln_g_0, ln_b_0, ffn_gu_0, ffn_down_0, w_in_0, w_out_0),
        (w_mod_1, b_mod_1, ln_g_1, ln_b_1, ffn_gu_1, ffn_down_1, w_in_1, w_out_1),
    )
    mixer_params = (
        (rwkv_mu_0, rwkv_w0_0, rwkv_w2_0, rwkv_a0_0, rwkv_a2_0, rwkv_g2_0, rwkv_k_k_0, rwkv_k_a_0,
         rwkv_r_k_0, rwkv_gn_g_0, rwkv_gn_b_0, na_rpb_0),
        (gla_g2_1, gla_gb_1, gla_norm_g_1, diff_lambda_1, diff_norm_g_1),
    )
    b_ = x.shape[0]
    xl, xc = x, ctx
    for l in range(DEPTH):
        w_mod, b_mod, ln_g, ln_b, ffn_gu, ffn_down, w_in, w_out = per_layer[l]
        need_ctx = l < DEPTH - 1
        m = (jax.nn.silu(c) @ w_mod + b_mod).reshape(b_, N_MOD, 1, D_MODEL)
        mc = (jax.nn.silu(c_ctx) @ w_mod + b_mod).reshape(N_MOD, 1, 1, D_MODEL)
        ml = [m[:, i] for i in range(N_MOD)]
        mcx = [mc[i] for i in range(N_MOD)]
        xl = half_ffn_update(xl, ml[0:3], ffn_gu[0], ffn_down[0], ln_g[0], ln_b[0])
        xc = half_ffn_update(xc, mcx[0:3], ffn_gu[0], ffn_down[0], ln_g[0], ln_b[0])
        h = modulate(xl, ml[3], ml[4])
        hc = modulate(xc, mcx[3], mcx[4])
        if l % 2 == 0:
            y, yc = rwkv_na_mixer(h, hc, w_in, w_out, *mixer_params[l], need_ctx=need_ctx)
        else:
            y, yc = gla_diff_mixer(h, hc, w_in, w_out, *mixer_params[l],
                                   lambda_init=0.8 - 0.6 * math.exp(-0.3 * l), need_ctx=need_ctx)
        xl = post_norm(xl, y, ml[5], ln_g[1], ln_b[1])
        if need_ctx:
            xc = post_norm(xc, yc, mcx[5], ln_g[1], ln_b[1])
        xl = half_ffn_update(xl, ml[6:9], ffn_gu[1], ffn_down[1], ln_g[2], ln_b[2])
        if need_ctx:
            xc = half_ffn_update(xc, mcx[6:9], ffn_gu[1], ffn_down[1], ln_g[2], ln_b[2])
    return xl
```

```cpp
#include <hip/hip_runtime.h>
#include <cstdio>
#include <cstdint>
namespace pg8 {
#define PG8_LAS __attribute__((address_space(3)))
typedef unsigned short bf16_t;
typedef short bf16x8 __attribute__((ext_vector_type(8)));
typedef float f32x4 __attribute__((ext_vector_type(4)));
typedef unsigned u32x4 __attribute__((ext_vector_type(4)));
constexpr int BM = 256, BK = 64, HALF = 128, HTB = HALF * BK * 2  , STAGE_BYTES = 8 * HTB, NXCD = 8, WGM = 8;

__host__ __device__ __forceinline__ int lds_byte(int r, int c) { const int st = (r >> 4) * 2 + (c >> 5), rr = r & 15, cc = c & 31, ob = rr * 64 + cc * 2; return st * 1024 + (ob ^ (((ob >> 9) & 1) << 5)); }
__host__ __device__ __forceinline__ void stage_rc(int b, int& R, int& C) { const int st = b / 1024, sb = b % 1024, swz = sb ^ (((sb >> 9) & 1) << 5); R = (st >> 1) * 16 + swz / 64; C = (st & 1) * 32 + (swz % 64) / 2; }
__host__ __device__ __forceinline__ int perm32(int rho) { const int n = rho >> 4, i = rho & 15; return 8 * (i >> 2) + 4 * n + (i & 3); }

struct Unit { int pm, pn; };
struct Gemm { const bf16_t* A; const bf16_t* Bt; int M, N, K; };

struct StaticOrder {
    int nM, nN, nwg, G, c;
    __host__ __device__ void init(int M, int N, int G_, int c_) { nM = M / BM; nN = N / BM; nwg = nM * nN; G = G_; c = c_; }
    __host__ __device__ bool next(int i, Unit& u) const {
        const long L = (long)i * G + c; if (L >= nwg) return false;
        int wgid = (int)L; { const int q = nwg / NXCD, r = nwg % NXCD, xcd = wgid % NXCD, off = wgid / NXCD; wgid = (xcd < r ? xcd * (q + 1) : r * (q + 1) + (xcd - r) * q) + off; }
        const int nig = WGM * nN, gid = wgid / nig, fm = gid * WGM, gsz = (nM - fm) < WGM ? (nM - fm) : WGM;
        u.pm = fm + ((wgid % nig) % gsz); u.pn = (wgid % nig) / gsz; return true;
    }
    __device__ __forceinline__ void a_ready(const Unit&) const {}
    __device__ __forceinline__ void done(const Unit&) const {}
};

__device__ __forceinline__ unsigned cvt_pk_bf16(float lo, float hi) { unsigned r; asm volatile("v_cvt_pk_bf16_f32 %0, %1, %2" : "=v"(r) : "v"(lo), "v"(hi)); return r; }
typedef unsigned u32x2 __attribute__((ext_vector_type(2)));
__device__ __forceinline__ float silu_f(float x) { return x * __builtin_amdgcn_rcpf(1.0f + __expf(-x)); }

struct EpiGU {
    static constexpr bool PERM = true, AFTER_DRAIN = false;
    bf16_t* O; int ldo;
    __device__ __forceinline__ void operator()(const f32x4 (&acc)[2][2][4][2], const Unit& u, int wr, int wc, int fr, int fq) const {
        const int row0 = u.pm * BM + wr * 64 + fr, j0 = u.pn * 128 + wc * 16 + 4 * fq;
#pragma unroll
        for (int ai = 0; ai < 2; ++ai)
#pragma unroll
            for (int m = 0; m < 4; ++m) { bf16_t* rowp = O + (size_t)(row0 + ai * HALF + m * 16) * ldo + j0;
#pragma unroll
                for (int bj = 0; bj < 2; ++bj) { const f32x4 g = acc[ai][bj][m][0], up = acc[ai][bj][m][1];
                    u32x2 w; w.x = cvt_pk_bf16(silu_f(g[0]) * up[0], silu_f(g[1]) * up[1]); w.y = cvt_pk_bf16(silu_f(g[2]) * up[2], silu_f(g[3]) * up[3]);
                    *(u32x2*)(rowp + bj * 64) = w; } }
    }
};
struct EpiRes {
    static constexpr bool PERM = false, AFTER_DRAIN = false;
    const float* resid_lat; const float* resid_ctx; float* out_lat; float* out_ctx; const float* modl; int gidx; float gs, alpha;
    __device__ __forceinline__ void operator()(const f32x4 (&acc)[2][2][4][2], const Unit& u, int wr, int wc, int fr, int fq) const {
        const int col0 = u.pn * BM + wc * 32 + 4 * fq; const bool isctx = u.pm >= 128; const int set = isctx ? 16 : (u.pm >> 3);
        const int rloc = (isctx ? (u.pm - 128) : u.pm) * BM + wr * 64 + fr;
        const float* rb = isctx ? resid_ctx : resid_lat; float* ob = isctx ? out_ctx : out_lat; const float* gp = modl + (size_t)(set * 9 + gidx) * 1024 + col0;
        f32x4 gv[2][2];
#pragma unroll
        for (int bj = 0; bj < 2; ++bj)
#pragma unroll
            for (int n = 0; n < 2; ++n) gv[bj][n] = *(const f32x4*)(gp + bj * HALF + n * 16) * gs;
#pragma unroll
        for (int ai = 0; ai < 2; ++ai)
#pragma unroll
            for (int m = 0; m < 4; ++m) { const size_t off = (size_t)(rloc + ai * HALF + m * 16) * 1024 + col0;
#pragma unroll
                for (int bj = 0; bj < 2; ++bj)
#pragma unroll
                    for (int n = 0; n < 2; ++n) { const f32x4 x = *(const f32x4*)(rb + off + bj * HALF + n * 16);
                        *(f32x4*)(ob + off + bj * HALF + n * 16) = x * alpha + gv[bj][n] * acc[ai][bj][m][n]; } }
    }
};
struct EpiIn {
    static constexpr bool PERM = true, AFTER_DRAIN = false;
    bf16_t* Oa; int lda; int split; bf16_t* Ob; int ldb; int nvalid; int s1lo, s1hi, s2lo, s2hi;
    __device__ __forceinline__ void operator()(const f32x4 (&acc)[2][2][4][2], const Unit& u, int wr, int wc, int fr, int fq) const {
        const int row0 = u.pm * BM + wr * 64 + fr;
#pragma unroll
        for (int bj = 0; bj < 2; ++bj) { const int c0 = u.pn * BM + bj * HALF + wc * 32 + 8 * fq;
            if (c0 < nvalid) { const float sc = ((c0 >= s1lo && c0 < s1hi) || (c0 >= s2lo && c0 < s2hi)) ? 0.125f : 1.0f;
                bf16_t* base = (c0 < split) ? (Oa + c0) : (Ob + (c0 - split)); const int ld = (c0 < split) ? lda : ldb;
#pragma unroll
                for (int ai = 0; ai < 2; ++ai)
#pragma unroll
                    for (int m = 0; m < 4; ++m) { const f32x4 v0 = acc[ai][bj][m][0] * sc, v1 = acc[ai][bj][m][1] * sc;
                        u32x4 w; w.x = cvt_pk_bf16(v0[0], v0[1]); w.y = cvt_pk_bf16(v0[2], v0[3]); w.z = cvt_pk_bf16(v1[0], v1[1]); w.w = cvt_pk_bf16(v1[2], v1[3]);
                        *(u32x4*)(base + (size_t)(row0 + ai * HALF + m * 16) * ld) = w; } } }
    }
};
template <class Epi, class Sched, bool ALIGN_EPI = false, bool SP2 = false>
__device__ __forceinline__ void gemm_phase(PG8_LAS unsigned char* lds, const Gemm g, const Sched& S, const Epi& E) {
    const int tid = threadIdx.x, wid = __builtin_amdgcn_readfirstlane(tid >> 6), lane = tid & 63, wr = wid >> 2, wc = wid & 3, fr = lane & 15, fq = lane >> 4;
    const int K = g.K, nt = K / BK;
    unsigned voffA[2], voffB[2];
#pragma unroll
    for (int i = 0; i < 2; ++i) { int R, C; stage_rc(tid * 16 + i * 8192, R, C); const int Rb = Epi::PERM ? ((R & ~31) + perm32(R & 31)) : R;
        voffA[i] = (unsigned)(R * K + C) * 2u; voffB[i] = (unsigned)(Rb * K + C) * 2u; }
    const size_t kstep = (size_t)(BK * 2);
    const size_t hstep = (size_t)HALF * K * 2;
    const size_t tstep = 2 * hstep;
    const unsigned ldsw = (unsigned)wid * 1024u;
    const int aoff = lds_byte(wr * 64 + fr, fq * 8), boff = lds_byte(wc * 32 + fr, fq * 8);
#define PG8_SA(b, h) (((b) * 2 + (h)) * HTB)
#define PG8_SB(b, h) ((4 + (b) * 2 + (h)) * HTB)
#define PG8_STAGE(bufoff, gbase, voff) do { _Pragma("unroll") for (int _i = 0; _i < 2; ++_i) \
        __builtin_amdgcn_global_load_lds((const unsigned*)((const char*)(gbase) + (voff)[_i]), (PG8_LAS unsigned*)(lds + (bufoff) + ldsw + _i * 8192), 16, 0, 0); } while (0)
#define PG8_LDA(dst, b, h) do { _Pragma("unroll") for (int m = 0; m < 4; ++m) _Pragma("unroll") for (int k = 0; k < 2; ++k) dst[m][k] = *(const PG8_LAS bf16x8*)(lds + PG8_SA(b, h) + aoff + m * 2048 + k * 1024); } while (0)
#define PG8_LDB(dst, b, h) do { _Pragma("unroll") for (int n = 0; n < 2; ++n) _Pragma("unroll") for (int k = 0; k < 2; ++k) dst[n][k] = *(const PG8_LAS bf16x8*)(lds + PG8_SB(b, h) + boff + n * 2048 + k * 1024); } while (0)
#define PG8_MMA(ai, bj, At, Bt) do { __builtin_amdgcn_s_setprio(1); _Pragma("unroll") for (int m = 0; m < 4; ++m) _Pragma("unroll") for (int n = 0; n < 2; ++n) _Pragma("unroll") for (int k = 0; k < 2; ++k) \
        acc[ai][bj][m][n] = __builtin_amdgcn_mfma_f32_16x16x32_bf16(Bt[n][k], At[m][k], acc[ai][bj][m][n], 0, 0, 0); __builtin_amdgcn_s_setprio(0); } while (0)
#define PG8_WAIT_V(n) asm volatile("s_waitcnt vmcnt(" #n ")" ::: "memory")
#define PG8_WAIT_L(n) asm volatile("s_waitcnt lgkmcnt(" #n ")" ::: "memory")
#define PG8_BAR __builtin_amdgcn_s_barrier()
#define PG8_SCHED __builtin_amdgcn_sched_barrier(0)
    Unit cur, nxt; int ui = 0;
    if (!S.next(0, cur)) return;
    f32x4 acc[2][2][4][2];
#pragma unroll
    for (int a = 0; a < 2; ++a)
#pragma unroll
        for (int b = 0; b < 2; ++b)
#pragma unroll
            for (int m = 0; m < 4; ++m)
#pragma unroll
                for (int n = 0; n < 2; ++n) acc[a][b][m][n] = (f32x4){0.f, 0.f, 0.f, 0.f};
    bf16x8 At[4][2], B0[2][2], B1[2][2];
    const char* cA = (const char*)g.A + (size_t)cur.pm * tstep; const char* cB = (const char*)g.Bt + (size_t)cur.pn * tstep;
    S.a_ready(cur);
    if constexpr (SP2) {
        PG8_STAGE(PG8_SB(0, 0), cB, voffB); PG8_STAGE(PG8_SB(0, 1), cB + hstep, voffB); PG8_STAGE(PG8_SA(0, 0), cA, voffA); PG8_STAGE(PG8_SA(0, 1), cA + hstep, voffA);
        if (wr == 1) PG8_BAR;
        PG8_WAIT_V(2); PG8_BAR;
        PG8_STAGE(PG8_SB(1, 0), cB + kstep, voffB); PG8_STAGE(PG8_SA(1, 0), cA + kstep, voffA); PG8_STAGE(PG8_SB(1, 1), cB + hstep + kstep, voffB);
        PG8_WAIT_V(6); PG8_BAR;
    } else {
        PG8_STAGE(PG8_SB(0, 0), cB, voffB); PG8_STAGE(PG8_SA(0, 0), cA, voffA); PG8_STAGE(PG8_SB(0, 1), cB + hstep, voffB); PG8_STAGE(PG8_SA(0, 1), cA + hstep, voffA);
        if (wr == 1) PG8_BAR;
        PG8_WAIT_V(4); PG8_BAR;
        PG8_STAGE(PG8_SB(1, 0), cB + kstep, voffB); PG8_STAGE(PG8_SA(1, 0), cA + kstep, voffA); PG8_STAGE(PG8_SB(1, 1), cB + hstep + kstep, voffB);
        PG8_WAIT_V(6); PG8_BAR;
    }
    for (;;) {
        const bool has_next = S.next(ui + 1, nxt);
        const char* nA = has_next ? (const char*)g.A + (size_t)nxt.pm * tstep : cA; const char* nB = has_next ? (const char*)g.Bt + (size_t)nxt.pn * tstep : cB;
        for (int t = 0; t < nt; t += 2) {
            const bool last = (t == nt - 2);
            const char* a1 = cA + (size_t)(t + 1) * kstep;
            const char* a2 = last ? nA : cA + (size_t)(t + 2) * kstep; const char* b2 = last ? nB : cB + (size_t)(t + 2) * kstep;
            const char* a3 = a2 + kstep; const char* b3 = b2 + kstep;
            if (last && has_next) S.a_ready(nxt);
            if constexpr (SP2) {
            PG8_LDB(B0, 0, 0); PG8_LDB(B1, 0, 1); PG8_SCHED; PG8_LDA(At, 0, 0); PG8_STAGE(PG8_SA(1, 1), a1 + hstep, voffA);
            PG8_WAIT_V(8); PG8_WAIT_L(0); PG8_BAR; PG8_MMA(0, 0, At, B0); PG8_MMA(0, 1, At, B1); PG8_BAR; PG8_SCHED;
            PG8_LDA(At, 0, 1); PG8_STAGE(PG8_SB(0, 0), b2, voffB); PG8_STAGE(PG8_SB(0, 1), b2 + hstep, voffB); PG8_STAGE(PG8_SA(0, 0), a2, voffA);
            PG8_WAIT_V(8); PG8_WAIT_L(0); PG8_BAR; PG8_MMA(1, 0, At, B0); PG8_MMA(1, 1, At, B1); PG8_BAR; PG8_SCHED;
            PG8_LDB(B0, 1, 0); PG8_LDB(B1, 1, 1); PG8_SCHED; PG8_LDA(At, 1, 0); PG8_STAGE(PG8_SA(0, 1), a2 + hstep, voffA);
            PG8_WAIT_V(8); PG8_WAIT_L(0); PG8_BAR; PG8_MMA(0, 0, At, B0); PG8_MMA(0, 1, At, B1); PG8_BAR; PG8_SCHED;
            PG8_LDA(At, 1, 1); PG8_STAGE(PG8_SB(1, 0), b3, voffB); PG8_STAGE(PG8_SB(1, 1), b3 + hstep, voffB); PG8_STAGE(PG8_SA(1, 0), a3, voffA);
            PG8_WAIT_V(8); PG8_WAIT_L(0); PG8_BAR; PG8_MMA(1, 0, At, B0); PG8_MMA(1, 1, At, B1); PG8_BAR; PG8_SCHED;
            } else {
            PG8_LDB(B0, 0, 0); PG8_SCHED; PG8_LDA(At, 0, 0); PG8_STAGE(PG8_SA(1, 1), a1 + hstep, voffA);
            PG8_WAIT_L(8); PG8_BAR; PG8_WAIT_L(0); PG8_MMA(0, 0, At, B0); PG8_BAR; PG8_SCHED;
            PG8_LDB(B1, 0, 1); PG8_STAGE(PG8_SB(0, 0), b2, voffB);
            PG8_BAR; PG8_WAIT_L(0); PG8_MMA(0, 1, At, B1); PG8_BAR;
            PG8_LDA(At, 0, 1); PG8_STAGE(PG8_SA(0, 0), a2, voffA);
            PG8_BAR; PG8_WAIT_L(0); PG8_MMA(1, 0, At, B0); PG8_BAR; PG8_SCHED;
            PG8_STAGE(PG8_SB(0, 1), b2 + hstep, voffB);
            PG8_WAIT_V(6); PG8_BAR; PG8_MMA(1, 1, At, B1); PG8_BAR;
            PG8_LDB(B0, 1, 0); PG8_SCHED; PG8_LDA(At, 1, 0); PG8_STAGE(PG8_SA(0, 1), a2 + hstep, voffA);
            PG8_WAIT_L(8); PG8_BAR; PG8_WAIT_L(0); PG8_MMA(0, 0, At, B0); PG8_BAR; PG8_SCHED;
            PG8_LDB(B1, 1, 1); PG8_STAGE(PG8_SB(1, 0), b3, voffB);
            PG8_BAR; PG8_WAIT_L(0); PG8_MMA(0, 1, At, B1); PG8_BAR;
            PG8_LDA(At, 1, 1); PG8_STAGE(PG8_SA(1, 0), a3, voffA);
            PG8_BAR; PG8_WAIT_L(0); PG8_MMA(1, 0, At, B0); PG8_BAR; PG8_SCHED;
            PG8_STAGE(PG8_SB(1, 1), b3 + hstep, voffB);
            PG8_WAIT_V(6); PG8_BAR; PG8_MMA(1, 1, At, B1); PG8_BAR;
            }
        }
        if constexpr (ALIGN_EPI) { if (wr == 0) PG8_BAR; }
        if constexpr (!Epi::AFTER_DRAIN) { E(acc, cur, wr, wc, fr, fq); S.done(cur); }
        if (!has_next) break;
#pragma unroll
        for (int a = 0; a < 2; ++a)
#pragma unroll
            for (int b = 0; b < 2; ++b)
#pragma unroll
                for (int m = 0; m < 4; ++m)
#pragma unroll
                    for (int n = 0; n < 2; ++n) acc[a][b][m][n] = (f32x4){0.f, 0.f, 0.f, 0.f};
        cur = nxt; cA = nA; cB = nB; ++ui;
        if constexpr (ALIGN_EPI) { if (wr == 1) PG8_BAR; }
    }
    PG8_WAIT_V(0);
    if constexpr (!ALIGN_EPI) { if (wr == 0) PG8_BAR; }
    PG8_BAR;
    if constexpr (Epi::AFTER_DRAIN) { E.fused(acc, cur, wr, wc, fr, fq, lds, wid, lane); S.done(cur); }
#undef PG8_SA
#undef PG8_SB
#undef PG8_STAGE
#undef PG8_LDA
#undef PG8_LDB
#undef PG8_MMA
#undef PG8_WAIT_V
#undef PG8_WAIT_L
#undef PG8_BAR
#undef PG8_SCHED
}
}

#ifndef DBG_Z_RWKV
#define DBG_Z_RWKV 0
#endif
#ifndef DBG_Z_NA
#define DBG_Z_NA 0
#endif
#ifndef DBG_Z_GLA
#define DBG_Z_GLA 0
#endif
#ifndef DBG_Z_DIFF
#define DBG_Z_DIFF 0
#endif
#ifndef DBG_NOYF
#define DBG_NOYF 0
#endif
#ifndef DBG_NOYB
#define DBG_NOYB 0
#endif
#ifndef DBG_NOBONUS
#define DBG_NOBONUS 0
#endif
#ifndef DBG_GLA_NOF
#define DBG_GLA_NOF 0
#endif
#ifndef DBG_GLA_NOB
#define DBG_GLA_NOB 0
#endif
#ifndef DBG_DIFF_LAM0
#define DBG_DIFF_LAM0 0
#endif
#ifndef DBG_NA_NOBIAS
#define DBG_NA_NOBIAS 0
#endif
#ifndef DBG_NA_NOLOCAL
#define DBG_NA_NOLOCAL 0
#endif
#ifndef DBG_NA_NOCTX
#define DBG_NA_NOCTX 0
#endif
#ifndef DBG_S_RWKV
#define DBG_S_RWKV 1.0f
#endif
#ifndef DBG_S_NA
#define DBG_S_NA 1.0f
#endif
#ifndef DBG_S_GLA
#define DBG_S_GLA 1.0f
#endif
#ifndef DBG_S_DIFF
#define DBG_S_DIFF 1.0f
#endif
#ifndef DBG_S_FFN
#define DBG_S_FFN 1.0f
#endif
#ifndef DBG_HZ_RWKV
#define DBG_HZ_RWKV(h) 0
#endif
#ifndef DBG_HZ_NA
#define DBG_HZ_NA(h) 0
#endif
#ifndef DBG_HZ_GLA
#define DBG_HZ_GLA(h) 0
#endif
#ifndef DBG_HZ_DIFF
#define DBG_HZ_DIFF(h) 0
#endif
#ifndef DBG_NOLW
#define DBG_NOLW 0
#endif
#ifndef DBG_NOLA
#define DBG_NOLA 0
#endif
#ifndef DBG_GLA_NOGD
#define DBG_GLA_NOGD 0
#endif
#ifndef DBG_MUS
#define DBG_MUS 1.0f
#endif
#ifndef DBG_ROPE
#define DBG_ROPE 0
#endif
#ifndef DBG_CHECKS
#define DBG_CHECKS 0
#endif
#ifndef REP_GEMM
#define REP_GEMM 1
#endif
#ifndef REP_NA
#define REP_NA 1
#endif
#ifndef REP_SCAN
#define REP_SCAN 1
#endif
#ifndef REP_POST
#define REP_POST 1
#endif
constexpr int NWAVES = 8;
constexpr int NB = 16, SEQ = 2048, CTXL = 256, D = 1024, FF = 2816, NGU = 5632, NMOD = 9, GRIDW = 64;
constexpr int M_LAT = NB * SEQ, M_CTX = NB * CTXL, M_ALL = M_LAT + M_CTX;
constexpr int NIN0 = 3456, NIN0P = 3584, NIN1 = 3104, NIN1P = 3328;
constexpr int UA_LD = 1920, UB_LD = 1536, U1_LD = 3104, NKEY = SEQ + CTXL;
constexpr float ALPHA = 1.41421356237f;
constexpr float LN_EPS = 1e-5f, RMS_EPS = 1e-6f, GN_EPS = 64e-5f;
constexpr float LAMBDA_INIT = 0.35550907f;

enum { I_X = 0, I_C, I_CTX, I_CCTX,
       I_WMOD0, I_BMOD0, I_LNG0, I_LNB0, I_GU0, I_DN0, I_WIN0, I_WOUT0, I_MU, I_W0, I_W2, I_A0, I_A2, I_G2, I_KK, I_KA, I_RK, I_GNG, I_GNB, I_RPB,
       I_WMOD1, I_BMOD1, I_LNG1, I_LNB1, I_GU1, I_DN1, I_WIN1, I_WOUT1, I_GLAG2, I_GLAGB, I_GLANG, I_DLAM, I_DNG, N_IN };
constexpr int LSTRIDE = I_WMOD1 - I_WMOD0;

constexpr size_t MiB = 1u << 20;
constexpr size_t WS_CTL = 0, CTL_BYTES = 1 * MiB;
constexpr size_t WS_MOD = 1 * MiB;
constexpr size_t WS_LORA = 4 * MiB;
constexpr size_t WS_W = 5 * MiB, W_LAYER = 42 * MiB;
constexpr size_t W_GU = 0, W_DN = 22 * MiB, W_IN = 33 * MiB, W_OUT = 40 * MiB;
constexpr size_t WS_XSC = 89 * MiB;
constexpr size_t WS_H = 105 * MiB;
constexpr size_t WS_R2 = 177 * MiB;
constexpr size_t WS_R3 = 375 * MiB;
constexpr size_t WS_VT0 = WS_R2 + 135 * MiB;
constexpr size_t WS_Y = WS_R2 + 135 * MiB;
constexpr size_t WS_VT1 = WS_R2 + 219 * MiB;
constexpr size_t WS_GOB = WS_R2 + 255 * MiB;
constexpr size_t WS_END = 489 * MiB;
static_assert(WS_Y + (size_t)2 * M_ALL * 512 * 4 <= WS_END, "Y");
static_assert(WS_GOB + (size_t)M_LAT * 512 * 2 <= WS_END && WS_VT0 + (size_t)NB * 8 * 64 * NKEY * 2 <= WS_R3 && (size_t)M_ALL * U1_LD * 2 <= 219 * MiB, "ws map");
constexpr int CW_BAR = 4096;
constexpr int CW_Q = 16384;

constexpr int LDS_BYTES = 163840 - 512;
constexpr int MISC_OFF = LDS_BYTES - 256;

#define GAS __attribute__((address_space(1)))
#define LAS __attribute__((address_space(3)))
typedef unsigned short bf16;
typedef unsigned v4u __attribute__((ext_vector_type(4)));
typedef unsigned v2u __attribute__((ext_vector_type(2)));
typedef float f32x4 __attribute__((ext_vector_type(4)));
typedef float f32x2 __attribute__((ext_vector_type(2)));
typedef float f32x16 __attribute__((ext_vector_type(16)));
typedef short bf16x8 __attribute__((ext_vector_type(8)));
typedef short s16x4 __attribute__((ext_vector_type(4)));
#define RLX_AGENT __ATOMIC_RELAXED, __HIP_MEMORY_SCOPE_AGENT
#define LDS_WAIT() asm volatile("s_waitcnt lgkmcnt(0)" ::: "memory")
#define VM_WAIT() asm volatile("s_waitcnt vmcnt(0)" ::: "memory")
#define MFMA32(a, b, c) __builtin_amdgcn_mfma_f32_32x32x16_bf16((a), (b), (c), 0, 0, 0)
__device__ __forceinline__ float bf2f(bf16 v) { return __uint_as_float(((unsigned)v) << 16); }
__device__ __forceinline__ float bflo(unsigned w) { return __uint_as_float(w << 16); }
__device__ __forceinline__ float bfhi(unsigned w) { return __uint_as_float(w & 0xffff0000u); }
typedef __bf16 bf16x2_t __attribute__((ext_vector_type(2)));
__device__ __forceinline__ unsigned pk2s(float lo, float hi) { const f32x2 v = {lo, hi}; const bf16x2_t b = __builtin_convertvector(v, bf16x2_t); return __builtin_bit_cast(unsigned, b); }
__device__ __forceinline__ bf16 f2bfs(float f) { return (bf16)(pk2s(f, 0.f) & 0xffffu); }
__device__ __forceinline__ unsigned pk2(float lo, float hi) { return pg8::cvt_pk_bf16(lo, hi); }
__device__ __forceinline__ bf16 f2bf(float f) { return (bf16)(pk2(f, 0.f) & 0xffffu); }
__device__ __forceinline__ float sigmoid_f(float x) { return 1.0f / (1.0f + __expf(-x)); }
__device__ __forceinline__ float xhalf_max(float v) { auto rr = __builtin_amdgcn_permlane32_swap(__float_as_uint(v), __float_as_uint(v), false, false); return fmaxf(__uint_as_float(rr[0]), __uint_as_float(rr[1])); }
__device__ __forceinline__ float xhalf_sum(float v) { auto rr = __builtin_amdgcn_permlane32_swap(__float_as_uint(v), __float_as_uint(v), false, false); return __uint_as_float(rr[0]) + __uint_as_float(rr[1]); }
template <int CTRL> __device__ __forceinline__ float dpp_f(float v) { return __uint_as_float((unsigned)__builtin_amdgcn_update_dpp(0, (int)__float_as_uint(v), CTRL, 0xf, 0xf, false)); }
__device__ __forceinline__ float row16_sum(float v) {
    v += dpp_f<0xB1>(v); v += dpp_f<0x4E>(v); v += dpp_f<0x141>(v); v += dpp_f<0x140>(v); return v;
}

__device__ __forceinline__ float wave_sum(float v) { v = row16_sum(v); v += __shfl_xor(v, 16); return xhalf_sum(v); }

struct Args { const float* in[N_IN]; float* out; unsigned char* ws; int ph_lo, ph_hi; };
struct Blk { LAS unsigned char* lds; int tid, lane, wave, G, bid; };
#define XB_TMO      128
#define XB_XCNT(j)  (256  + 64 * (j))
#define XB_XSUB(j)  (1280 + 64 * (j))
#define XB_XGEN(j)  (2304 + 64 * (j))
#define XB_TOP      3328
#define XB_TOPGEN   3392
#define XCD_BAR_WORDS 3456
#define XB_SPIN_CAP (1u << 18)

__device__ __forceinline__ unsigned xb_ld(unsigned* p)              { return __hip_atomic_load(p, __ATOMIC_RELAXED, __HIP_MEMORY_SCOPE_AGENT); }
__device__ __forceinline__ unsigned xb_add(unsigned* p, unsigned v) { return __hip_atomic_fetch_add(p, v, __ATOMIC_RELAXED, __HIP_MEMORY_SCOPE_AGENT); }
__device__ __forceinline__ unsigned xb_xcc_id() { return (unsigned)__builtin_amdgcn_s_getreg((3 << 11) | 20) & 0xFu; }
#define XB_SPIN(cond, bar) do { unsigned _sp = 0; while (cond) { __builtin_amdgcn_s_sleep(1); \
    if ((++_sp & 255u) == 0u) { if (xb_ld(&(bar)[XB_TMO])) break; if (_sp > XB_SPIN_CAP) { atomicAdd(&(bar)[XB_TMO], 1u); break; } } } } while (0)

struct XcdBarrier {
    unsigned* bar; unsigned x;
    volatile LAS unsigned* st;
};

__device__ __forceinline__ XcdBarrier xcd_barrier_post(unsigned* bar, volatile LAS unsigned* st) {
    XcdBarrier b; b.bar = bar; b.x = xb_xcc_id(); b.st = st;
    if (threadIdx.x == 0) (void)xb_add(&bar[XB_XCNT(b.x)], 1u);
    return b;
}
__device__ __forceinline__ void xcd_barrier_complete(unsigned* bar, unsigned x, unsigned& nloc, unsigned& nx) {
    const unsigned G = gridDim.x * gridDim.y * gridDim.z;
    unsigned sum, cnt, mine, sp = 0u;
    for (;;) {
        sum = 0u; cnt = 0u; mine = 0u;
#pragma unroll
        for (unsigned j = 0; j < 16; ++j) { const unsigned c = xb_ld(&bar[XB_XCNT(j)]); sum += c; cnt += (c > 0u) ? 1u : 0u; mine = (j == x) ? c : mine; }
        if (sum == G) break;
        __builtin_amdgcn_s_sleep(1);
        if ((++sp & 255u) == 0u) { if (xb_ld(&bar[XB_TMO])) break; if (sp > XB_SPIN_CAP) { atomicAdd(&bar[XB_TMO], 1u); break; } }
    }
    nloc = mine > 0u ? mine : 1u; nx = cnt > 0u ? cnt : 1u;
}

__device__ __forceinline__ void xcd_barrier(const XcdBarrier& b) {
    asm volatile("s_waitcnt vmcnt(0)" ::: "memory");
    __syncthreads();
    if (threadIdx.x == 0) {
        unsigned* bar = b.bar;
        __builtin_amdgcn_s_waitcnt(0);
        unsigned nloc = b.st[0], nx = b.st[1];
        if (nloc == 0u) { xcd_barrier_complete(bar, b.x, nloc, nx); b.st[0] = nloc; b.st[1] = nx; }
        const unsigned old = xb_add(&bar[XB_XSUB(b.x)], 1u);
        const unsigned gen = old / nloc;
        if (old + 1u == (gen + 1u) * nloc) {
            __builtin_amdgcn_fence(__ATOMIC_RELEASE, "agent");
            asm volatile("s_waitcnt vmcnt(0)" ::: "memory");
            const unsigned og = xb_add(&bar[XB_TOP], 1u);
            const unsigned tg = og / nx;
            if (og + 1u == (tg + 1u) * nx) xb_add(&bar[XB_TOPGEN], 1u);
            else XB_SPIN(xb_ld(&bar[XB_TOPGEN]) == tg, bar);
            __builtin_amdgcn_fence(__ATOMIC_ACQUIRE, "agent");
            xb_add(&bar[XB_XGEN(b.x)], 1u);
            asm volatile("s_waitcnt vmcnt(0)" ::: "memory");
        } else {
            XB_SPIN(xb_ld(&bar[XB_XGEN(b.x)]) == gen, bar);
            __builtin_amdgcn_fence(__ATOMIC_ACQUIRE, "agent");
            asm volatile("s_waitcnt vmcnt(0)" ::: "memory");
        }
    }
    __syncthreads();
}

__device__ __forceinline__ void p0_transpose_item(const float* W, int K, int N, bf16* WT, int mode, LAS float* scr, int item, int lane) {
    const int nblk = N / 32, kb = item / nblk, nb = item % nblk, k0 = 64 * kb, n0 = 32 * nb;
#pragma unroll 32
    for (int i = 0; i < 32; ++i) { const int kk = 2 * i + (lane >> 5); scr[kk * 33 + (lane & 31)] = W[(size_t)(k0 + kk) * N + n0 + (lane & 31)]; }
    LDS_WAIT(); asm volatile("" ::: "memory");
    const int c = lane & 7;
#pragma unroll
    for (int j = 0; j < 4; ++j) { const int n = (lane >> 3) + 8 * j; const LAS float* s = scr + (8 * c) * 33 + n;
        v4u o; o.x = pk2(s[0 * 33], s[1 * 33]); o.y = pk2(s[2 * 33], s[3 * 33]); o.z = pk2(s[4 * 33], s[5 * 33]); o.w = pk2(s[6 * 33], s[7 * 33]);
        int dr = n0 + n;
        if (mode == 1) { const int isup = dr >= FF ? 1 : 0, jj = dr - isup * FF; dr = (jj >> 2) * 8 + isup * 4 + (jj & 3); }
        *(v4u*)(WT + (size_t)dr * K + k0 + 8 * c) = o; }
    LDS_WAIT(); asm volatile("" ::: "memory");
}
__device__ __forceinline__ bf16* wptr(const Args& a, int l, size_t off) { return (bf16*)(a.ws + WS_W + (size_t)l * W_LAYER + off); }
__device__ __forceinline__ float* modptr(const Args& a, int l) { return (float*)(a.ws + WS_MOD) + (size_t)l * 17 * NMOD * D; }

__device__ __forceinline__ void p0_prologue(const Args& a, const Blk& B) {
    LAS float* scr = (LAS float*)(B.lds + B.wave * 16384);
    const int gw = B.bid * NWAVES + B.wave, NGW = B.G * NWAVES;
    constexpr int I_GU = 16 * (NGU / 32), I_DN = (FF / 64) * (D / 32), I_IN0 = 16 * (NIN0 / 32), I_IN1 = 16 * (NIN1 / 32), I_OUT = 16 * 32;
    constexpr int PER0 = 2 * I_GU + 2 * I_DN + I_IN0 + I_OUT, PER1 = 2 * I_GU + 2 * I_DN + I_IN1 + I_OUT;
    for (int it = gw; it < PER0 + PER1; it += NGW) {
        const int l = it >= PER0 ? 1 : 0; int r = it - l * PER0; const int lo = l * LSTRIDE;
        if (r < 2 * I_GU) { const int s = r / I_GU; p0_transpose_item(a.in[I_GU0 + lo] + (size_t)s * D * NGU, D, NGU, wptr(a, l, W_GU) + (size_t)s * NGU * D, 1, scr, r % I_GU, B.lane); continue; } r -= 2 * I_GU;
        if (r < 2 * I_DN) { const int s = r / I_DN; p0_transpose_item(a.in[I_DN0 + lo] + (size_t)s * FF * D, FF, D, wptr(a, l, W_DN) + (size_t)s * D * FF, 0, scr, r % I_DN, B.lane); continue; } r -= 2 * I_DN;
        const int iin = l ? I_IN1 : I_IN0;
        if (r < iin) { p0_transpose_item(a.in[I_WIN0 + lo], D, l ? NIN1 : NIN0, wptr(a, l, W_IN), 0, scr, r, B.lane); continue; } r -= iin;
        p0_transpose_item(a.in[I_WOUT0 + lo], D, D, wptr(a, l, W_OUT), 0, scr, r, B.lane);
    }
    { bf16* lt = (bf16*)(a.ws + WS_LORA);
      for (int i = B.bid * 512 + B.tid; i < 2 * 512 * 64 * 2 + 512 * 128; i += B.G * 512) {
          if (i < 2 * 65536) { const int which = i >> 16, j = i & 65535, d = j >> 15, ch = (j >> 6) & 511, k = j & 63;
              lt[i] = f2bf(a.in[which ? I_A2 : I_W2][(size_t)d * 64 * 512 + (size_t)k * 512 + ch]); }
          else { const int j = i - 2 * 65536, ch = j >> 7, k = j & 127; lt[i] = f2bf(a.in[I_G2][(size_t)k * 512 + ch]); } } }
    __syncthreads();
    LAS float* SC = (LAS float*)B.lds;
    LAS float* PS = (LAS float*)(B.lds + 1024 * 20 * 4);
    bool have_sc = false;
    for (int u = B.bid; u < 288; u += B.G) {
        if (!have_sc) { for (int i = B.tid; i < 17 * 1024; i += 512) { const int s = i >> 10, k = i & 1023; const float c = s < 16 ? a.in[I_C][s * 1024 + k] : a.in[I_CCTX][k]; SC[k * 20 + s] = c * sigmoid_f(c); }
                        have_sc = true; __syncthreads(); }
        const int l = u / 144, cb = u % 144, col = cb * 64 + B.lane; const float* W = a.in[I_WMOD0 + l * LSTRIDE];
        float acc[17];
#pragma unroll
        for (int s = 0; s < 17; ++s) acc[s] = 0.f;
        const int kbeg = B.wave * 128;
#pragma unroll 16
        for (int k = kbeg; k < kbeg + 128; ++k) { const float w = W[(size_t)k * (NMOD * D) + col]; const LAS float* sc = SC + k * 20;
            const f32x4 s0 = *(const LAS f32x4*)(sc), s1 = *(const LAS f32x4*)(sc + 4), s2 = *(const LAS f32x4*)(sc + 8), s3 = *(const LAS f32x4*)(sc + 12); const float s4 = sc[16];
#pragma unroll
            for (int j = 0; j < 4; ++j) { acc[j] += s0[j] * w; acc[4 + j] += s1[j] * w; acc[8 + j] += s2[j] * w; acc[12 + j] += s3[j] * w; }
            acc[16] += s4 * w; }
#pragma unroll
        for (int s = 0; s < 17; ++s) PS[(B.wave * 17 + s) * 64 + B.lane] = acc[s];
        __syncthreads();
        for (int i = B.tid; i < 17 * 64; i += 512) { const int s = i >> 6, cc = i & 63; float t = 0.f;
#pragma unroll
            for (int w = 0; w < 8; ++w) t += PS[(w * 17 + s) * 64 + cc];
            const int n = cb * 64 + cc; modptr(a, l)[(size_t)s * (NMOD * D) + n] = t + a.in[I_BMOD0 + l * LSTRIDE][n]; }
        __syncthreads();
    }
}

__device__ __forceinline__ void p1_h0(const Args& a, const Blk& B) {
    const int gw = B.bid * NWAVES + B.wave, NGW = B.G * NWAVES; bf16* H = (bf16*)(a.ws + WS_H); const float* mod = modptr(a, 0);
    for (int row = gw; row < M_ALL; row += NGW) {
        const float* xr = row < M_LAT ? a.in[I_X] + (size_t)row * D : a.in[I_CTX] + (size_t)(row - M_LAT) * D; const int set = row < M_LAT ? row >> 11 : 16;
        const float* sh = mod + (size_t)(set * 9 + 0) * D, *sc = mod + (size_t)(set * 9 + 1) * D;
#pragma unroll
        for (int j = 0; j < 4; ++j) { const int c = 4 * B.lane + 256 * j; const f32x4 x = *(const f32x4*)(xr + c), s1 = *(const f32x4*)(sc + c), s0 = *(const f32x4*)(sh + c);
            const f32x4 h = x * (s1 + 1.0f) + s0; v2u o; o.x = pk2(h[0], h[1]); o.y = pk2(h[2], h[3]); *(v2u*)(H + (size_t)row * D + c) = o; }
    }
}
__device__ __forceinline__ void ln_phase(const Blk& B, float* xs_lat, float* xs_ctx, int nrows, const float* lng, const float* lnb, const float* mod, int i_shift, int i_scale, bf16* H) {
    const int gw = B.bid * NWAVES + B.wave, NGW = B.G * NWAVES;
    for (int row0 = gw; row0 < nrows; row0 += 2 * NGW) {
        const int row1 = row0 + NGW; const bool has1 = row1 < nrows; const int rr1 = has1 ? row1 : row0;
        float* xr0 = row0 < M_LAT ? xs_lat + (size_t)row0 * D : xs_ctx + (size_t)(row0 - M_LAT) * D; float* xr1 = rr1 < M_LAT ? xs_lat + (size_t)rr1 * D : xs_ctx + (size_t)(rr1 - M_LAT) * D;
        f32x4 v0[4], v1[4]; float s0 = 0.f, s1 = 0.f;
#pragma unroll
        for (int j = 0; j < 4; ++j) { v0[j] = *(const f32x4*)(xr0 + 4 * B.lane + 256 * j); v1[j] = *(const f32x4*)(xr1 + 4 * B.lane + 256 * j); }
#pragma unroll
        for (int j = 0; j < 4; ++j) { s0 += (v0[j][0] + v0[j][1]) + (v0[j][2] + v0[j][3]); s1 += (v1[j][0] + v1[j][1]) + (v1[j][2] + v1[j][3]); }
        const float mean0 = wave_sum(s0) * (1.f / D), mean1 = wave_sum(s1) * (1.f / D); float q0 = 0.f, q1 = 0.f;
#pragma unroll
        for (int j = 0; j < 4; ++j) { v0[j] = v0[j] - mean0; v1[j] = v1[j] - mean1; q0 += (v0[j][0] * v0[j][0] + v0[j][1] * v0[j][1]) + (v0[j][2] * v0[j][2] + v0[j][3] * v0[j][3]); q1 += (v1[j][0] * v1[j][0] + v1[j][1] * v1[j][1]) + (v1[j][2] * v1[j][2] + v1[j][3] * v1[j][3]); }
        const float rstd0 = 1.0f / sqrtf(wave_sum(q0) * (1.f / D) + LN_EPS), rstd1 = 1.0f / sqrtf(wave_sum(q1) * (1.f / D) + LN_EPS);
#pragma unroll
        for (int half = 0; half < 2; ++half) { if (half && !has1) break; const int row = half ? row1 : row0; float* xr = half ? xr1 : xr0; const float rstd = half ? rstd1 : rstd0; const int set = row < M_LAT ? row >> 11 : 16;
#pragma unroll
            for (int j = 0; j < 4; ++j) { const int c = 4 * B.lane + 256 * j; const f32x4 g = *(const f32x4*)(lng + c), bb = *(const f32x4*)(lnb + c);
                const f32x4 x = (half ? v1[j] : v0[j]) * rstd * g + bb; *(f32x4*)(xr + c) = x;
                if (mod) { const f32x4 sc1 = *(const f32x4*)(mod + (size_t)(set * 9 + i_scale) * D + c), sh0 = *(const f32x4*)(mod + (size_t)(set * 9 + i_shift) * D + c);
                    const f32x4 h = x * (sc1 + 1.0f) + sh0; v2u o; o.x = pk2(h[0], h[1]); o.y = pk2(h[2], h[3]); *(v2u*)(H + (size_t)row * D + c) = o; } } }
    }
}

template <int DV> __device__ __forceinline__ void vt_build(const Blk& B, const bf16* U, int pitch, int colbase, int NH, bf16* VT) {
    constexpr int LP = DV + 8;
    LAS bf16* scr = (LAS bf16*)(B.lds + B.wave * (64 * LP * 2));
    const int gw = B.bid * NWAVES + B.wave, NGW = B.G * NWAVES, nunits = NB * NH * (NKEY / 64);
    for (int u = gw; u < nunits; u += NGW) {
        const int kt = u % (NKEY / 64), bh = u / (NKEY / 64), b = bh / NH, hs = bh % NH, key = kt * 64 + B.lane;
        const size_t row = key < SEQ ? (size_t)b * SEQ + key : (size_t)M_LAT + b * CTXL + (key - SEQ);
        const bf16* src = U + row * pitch + colbase + hs * DV;
#pragma unroll
        for (int i = 0; i < DV / 8; ++i) *(LAS v4u*)(scr + B.lane * LP + 8 * i) = *(const v4u*)(src + 8 * i);
        LDS_WAIT(); asm volatile("" ::: "memory");
#pragma unroll
        for (int p = 0; p < DV / 64; ++p) { const int dv = p * 64 + B.lane; bf16* dst = VT + ((size_t)bh * DV + dv) * NKEY + kt * 64;
#pragma unroll
            for (int c = 0; c < 8; ++c) { unsigned w[4];
#pragma unroll
                for (int e = 0; e < 4; ++e) { const unsigned lo = scr[(8 * c + 2 * e) * LP + dv], hi = scr[(8 * c + 2 * e + 1) * LP + dv]; w[e] = lo | (hi << 16); }
                v4u o; o.x = w[0]; o.y = w[1]; o.z = w[2]; o.w = w[3]; *(v4u*)(dst + 8 * c) = o; } }
        LDS_WAIT(); asm volatile("" ::: "memory");
    }
}

__device__ __forceinline__ f32x16 qk_tile(const bf16* krow, const bf16x8 (&qf)[4], int hh) {
    f32x16 s;
#pragma unroll
    for (int e = 0; e < 16; ++e) s[e] = 0.f;
#pragma unroll
    for (int ks = 0; ks < 4; ++ks) { const bf16x8 kf = *(const bf16x8*)(krow + 16 * ks + 8 * hh); s = MFMA32(kf, qf[ks], s); }
    return s;
}
__device__ __forceinline__ void sm_update(f32x16& s, float& m, float& l, float& alpha, bf16x8& p0, bf16x8& p1) {
    float tm = s[0];
#pragma unroll
    for (int e = 1; e < 16; ++e) tm = fmaxf(tm, s[e]);
    tm = xhalf_max(tm);
    const float mn = fmaxf(m, tm); alpha = __expf(m - mn); m = mn; float ps = 0.f;
#pragma unroll
    for (int e = 0; e < 16; ++e) { s[e] = __expf(s[e] - mn); ps += s[e]; }
    l = l * alpha + ps;
    v4u a, b; a.x = pk2(s[0], s[1]); a.y = pk2(s[2], s[3]); a.z = pk2(s[4], s[5]); a.w = pk2(s[6], s[7]); b.x = pk2(s[8], s[9]); b.y = pk2(s[10], s[11]); b.z = pk2(s[12], s[13]); b.w = pk2(s[14], s[15]);
    p0 = __builtin_bit_cast(bf16x8, a); p1 = __builtin_bit_cast(bf16x8, b);
}
__device__ __forceinline__ bf16x8 vt_frag(const bf16* vrow, int ks, int hh) {
    const v2u lo = *(const v2u*)(vrow + 16 * ks + 4 * hh), hi = *(const v2u*)(vrow + 16 * ks + 8 + 4 * hh);
    v4u w; w.x = lo.x; w.y = lo.y; w.z = hi.x; w.w = hi.y; return __builtin_bit_cast(bf16x8, w);
}

__device__ __forceinline__ void na_phase(const Args& a, const Blk& B) {
    const bf16* UB = (const bf16*)(a.ws + WS_R3); const bf16* VT = (const bf16*)(a.ws + WS_VT0); bf16* YM = (bf16*)(a.ws + WS_H);
    LAS float* rpb = (LAS float*)B.lds;
    for (int i = B.tid; i < 8 * 15 * 31; i += 512) rpb[i] = a.in[I_RPB][i];
    __syncthreads();
    const int gw = B.bid * NWAVES + B.wave, NGW = B.G * NWAVES, r32 = B.lane & 31, hh = B.lane >> 5;
    constexpr int NLAT = NB * 8 * 32 * 2, NCTX = NB * 8 * 8;
    for (int u = gw; u < NLAT + NCTX; u += NGW) {
        const bool lat = u < NLAT; int b, h, r = 0, g = 0, tile = 0;
        if (lat) { g = u & 1; r = (u >> 1) & 31; h = (u >> 6) & 7; b = u >> 9; } else { const int v = u - NLAT; tile = v & 7; h = (v >> 3) & 7; b = v >> 6; }
        const size_t qrow = lat ? (size_t)b * SEQ + r * 64 + 32 * g + r32 : (size_t)M_LAT + b * CTXL + tile * 32 + r32;
        bf16x8 qf[4];
#pragma unroll
        for (int ks = 0; ks < 4; ++ks) qf[ks] = *(const bf16x8*)(UB + qrow * UB_LD + h * 64 + 16 * ks + 8 * hh);
        f32x16 O0, O1;
#pragma unroll
        for (int e = 0; e < 16; ++e) { O0[e] = 0.f; O1[e] = 0.f; }
        float m = -1e30f, l = 0.f;
        const bf16* vbase = VT + ((size_t)(b * 8 + h) * 64 + r32) * NKEY;
        for (int c = 0; c < ((DBG_NA_NOCTX && lat) ? 0 : 8); ++c) {
            const size_t krow = (size_t)M_LAT + b * CTXL + 32 * c + r32;
            f32x16 s = qk_tile(UB + krow * UB_LD + 512 + h * 64, qf, hh);
            float alpha; bf16x8 p0, p1; sm_update(s, m, l, alpha, p0, p1);
#pragma unroll
            for (int e = 0; e < 16; ++e) { O0[e] *= alpha; O1[e] *= alpha; }
            const bf16* v0 = vbase + SEQ + 32 * c; const bf16* v1 = v0 + (size_t)32 * NKEY;
            O0 = MFMA32(vt_frag(v0, 0, hh), p0, O0); O0 = MFMA32(vt_frag(v0, 1, hh), p1, O0);
            O1 = MFMA32(vt_frag(v1, 0, hh), p0, O1); O1 = MFMA32(vt_frag(v1, 1, hh), p1, O1);
        }
        if (lat && !DBG_NA_NOLOCAL) {
            const int rs = min(max(r - 4, 0), 24), qc = 32 * g + r32, cs = min(max(qc - 8, 0), 48);
            for (int i = 0; i < 8; ++i) for (int cg = 0; cg < 2; ++cg) {
                const int kr = rs + i, ktok = kr * 64 + 32 * cg;
                const size_t krow = (size_t)b * SEQ + ktok + r32;
                f32x16 s = qk_tile(UB + krow * UB_LD + 512 + h * 64, qf, hh);
                const LAS float* bias = rpb + (h * 15 + (kr - r + 7)) * 31;
#pragma unroll
                for (int e = 0; e < 16; ++e) { const int kc = 32 * cg + (e & 3) + 8 * (e >> 2) + 4 * hh; const bool ok = (kc >= cs) && (kc < cs + 16); const int dc = min(max(kc - qc + 15, 0), 30);
                    s[e] = ok ? s[e] + (DBG_NA_NOBIAS ? 0.f : bias[dc]) : -1e30f; }
                float alpha; bf16x8 p0, p1; sm_update(s, m, l, alpha, p0, p1);
#pragma unroll
                for (int e = 0; e < 16; ++e) { O0[e] *= alpha; O1[e] *= alpha; }
                const bf16* v0 = vbase + ktok; const bf16* v1 = v0 + (size_t)32 * NKEY;
                O0 = MFMA32(vt_frag(v0, 0, hh), p0, O0); O0 = MFMA32(vt_frag(v0, 1, hh), p1, O0);
                O1 = MFMA32(vt_frag(v1, 0, hh), p0, O1); O1 = MFMA32(vt_frag(v1, 1, hh), p1, O1);
            }
        }
        const float inv = (DBG_Z_NA || DBG_HZ_NA(h)) ? 0.f : DBG_S_NA / xhalf_sum(l);
        bf16* yo = YM + qrow * D + 512 + h * 64 + 4 * hh;
#pragma unroll
        for (int eg = 0; eg < 4; ++eg) { v2u o; o.x = pk2(O0[4 * eg] * inv, O0[4 * eg + 1] * inv); o.y = pk2(O0[4 * eg + 2] * inv, O0[4 * eg + 3] * inv); *(v2u*)(yo + 8 * eg) = o;
            v2u q; q.x = pk2(O1[4 * eg] * inv, O1[4 * eg + 1] * inv); q.y = pk2(O1[4 * eg + 2] * inv, O1[4 * eg + 3] * inv); *(v2u*)(yo + 32 + 8 * eg) = q; }
    }
}

__device__ __forceinline__ void ush8(const bf16* UA, size_t row, int c0, bool hp, bool hn, const float* mu, float (&o)[8]) {
    const v4u u0 = *(const v4u*)(UA + row * UA_LD + c0); v4u up, un;
    if (hp) up = *(const v4u*)(UA + (row - 1) * UA_LD + c0); else { up.x = 0; up.y = 0; up.z = 0; up.w = 0; }
    if (hn) un = *(const v4u*)(UA + (row + 1) * UA_LD + c0); else { un.x = 0; un.y = 0; un.z = 0; un.w = 0; }
    const f32x4 m0 = *(const f32x4*)(mu + c0) * DBG_MUS, m1 = *(const f32x4*)(mu + c0 + 4) * DBG_MUS;
    const unsigned a[4] = {u0.x, u0.y, u0.z, u0.w}, p[4] = {up.x, up.y, up.z, up.w}, n[4] = {un.x, un.y, un.z, un.w};
#pragma unroll
    for (int e = 0; e < 4; ++e) { const float x0 = bflo(a[e]), x1 = bfhi(a[e]); const float mm0 = e < 2 ? m0[2 * e] : m1[2 * e - 4], mm1 = e < 2 ? m0[2 * e + 1] : m1[2 * e - 3];
        o[2 * e] = x0 + mm0 * (0.5f * (bflo(p[e]) + bflo(n[e])) - x0); o[2 * e + 1] = x1 + mm1 * (0.5f * (bfhi(p[e]) + bfhi(n[e])) - x1); }
}
__device__ __forceinline__ void ush4(const bf16* UA, size_t row, int c0, bool hp, bool hn, const float* mu, float (&o)[4]) {
    const v2u u0 = *(const v2u*)(UA + row * UA_LD + c0); v2u up, un;
    if (hp) up = *(const v2u*)(UA + (row - 1) * UA_LD + c0); else { up.x = 0; up.y = 0; }
    if (hn) un = *(const v2u*)(UA + (row + 1) * UA_LD + c0); else { un.x = 0; un.y = 0; }
    const f32x4 m0 = *(const f32x4*)(mu + c0) * DBG_MUS;
    o[0] = bflo(u0.x) + m0[0] * (0.5f * (bflo(up.x) + bflo(un.x)) - bflo(u0.x)); o[1] = bfhi(u0.x) + m0[1] * (0.5f * (bfhi(up.x) + bfhi(un.x)) - bfhi(u0.x));
    o[2] = bflo(u0.y) + m0[2] * (0.5f * (bflo(up.y) + bflo(un.y)) - bflo(u0.y)); o[3] = bfhi(u0.y) + m0[3] * (0.5f * (bfhi(up.y) + bfhi(un.y)) - bfhi(u0.y));
}
__device__ __forceinline__ float ush1(const bf16* UA, size_t row, int c, bool hp, bool hn, const float* mu) {
    const float x0 = bf2f(UA[row * UA_LD + c]), xp = hp ? bf2f(UA[(row - 1) * UA_LD + c]) : 0.f, xn = hn ? bf2f(UA[(row + 1) * UA_LD + c]) : 0.f;
    return x0 + mu[c] * DBG_MUS * (0.5f * (xp + xn) - x0);
}
__device__ __forceinline__ void reduce8(const float (&x)[8], int lane, float& e0, float& e1) {
    float c[4];
#pragma unroll
    for (int i = 0; i < 4; ++i) { auto rr = __builtin_amdgcn_permlane32_swap(__float_as_uint(x[i]), __float_as_uint(x[i + 4]), false, false); c[i] = __uint_as_float(rr[0]) + __uint_as_float(rr[1]); }
    const bool odd = (lane >> 4) & 1;
    const float k0 = odd ? c[2] : c[0], s0 = odd ? c[0] : c[2], k1 = odd ? c[3] : c[1], s1 = odd ? c[1] : c[3];
    e0 = row16_sum(k0 + __shfl_xor(s0, 16)); e1 = row16_sum(k1 + __shfl_xor(s1, 16));
}

#define RW_GEOM(sg_, isctx_, T_, t0_, rowbase_) const bool isctx_ = (sg_) < 8; const int T_ = isctx_ ? CTXL : SEQ, t0_ = (isctx_ ? (dir ? 7 - (sg_) : (sg_)) : (dir ? 71 - (sg_) : (sg_) - 8)) * 32; \
    const size_t rowbase_ = isctx_ ? (size_t)M_LAT + b * CTXL : (size_t)b * SEQ
__device__ __forceinline__ void rwkv_scan_phase(const Args& a, const Blk& B) {
    const bf16* UA = (const bf16*)(a.ws + WS_R2); float* Y = (float*)(a.ws + WS_Y); const bf16* lora = (const bf16*)(a.ws + WS_LORA);
    LAS float* OPS = (LAS float*)B.lds; LAS float* VV = (LAS float*)(B.lds + 40960); LAS float* LW = (LAS float*)(B.lds + 49152); LAS float* LA = (LAS float*)(B.lds + 57344);
    const float* mu = a.in[I_MU]; const int r32 = B.lane & 31, hh = B.lane >> 5, lane = B.lane;
    for (int scan = B.bid; scan < 256; scan += B.G) {
        const int dir = scan & 1, h = (scan >> 1) & 7, b = scan >> 4, hc = h * 64 + lane;
        float S[8];
#pragma unroll
        for (int i = 0; i < 8; ++i) S[i] = 0.f;
        const float w0v = a.in[I_W0][dir * 512 + hc], a0v = a.in[I_A0][dir * 512 + hc], kkv = a.in[I_KK][hc], kav = a.in[I_KA][hc];
        const float mur = mu[hc], muk = mu[512 + hc], muv = mu[1024 + hc];
        const int which = B.wave & 1, colin = (which ? 1664 : 1536) + 64 * dir;
        unsigned pu[6][3]; v4u lx[4][3];
#define RW_PREFETCH(sg_) do { RW_GEOM(sg_, pc_, pT_, pt0_, prb_); (void)pc_; \
            _Pragma("unroll") for (int i = 0; i < 6; ++i) { int tt_ = pt0_ + 4 * B.wave - 1 + i; tt_ = tt_ < 0 ? 0 : (tt_ > pT_ - 1 ? pT_ - 1 : tt_); const bf16* p_ = UA + (prb_ + tt_) * UA_LD + hc; pu[i][0] = p_[0]; pu[i][1] = p_[512]; pu[i][2] = p_[1024]; } \
            if (B.wave < 2) { const int t_ = pt0_ + r32; const int tp_ = t_ > 0 ? t_ - 1 : t_, tn_ = t_ < pT_ - 1 ? t_ + 1 : t_; \
                _Pragma("unroll") for (int ks = 0; ks < 4; ++ks) { const int c_ = colin + 16 * ks + 8 * hh; lx[ks][0] = *(const v4u*)(UA + (prb_ + t_) * UA_LD + c_); lx[ks][1] = *(const v4u*)(UA + (prb_ + tp_) * UA_LD + c_); lx[ks][2] = *(const v4u*)(UA + (prb_ + tn_) * UA_LD + c_); } } } while (0)
        RW_PREFETCH(0);
        for (int sg = 0; sg < 72; ++sg) {
            RW_GEOM(sg, isctx, T, t0, rowbase); (void)isctx;
            if (B.wave < 2) {
                const bf16* wT = lora + (size_t)which * 65536 + (size_t)(dir * 512 + h * 64) * 64;
                const int t = t0 + r32; const bool hp = t > 0, hn = t < T - 1; bf16x8 bfr[4];
#pragma unroll
                for (int ks = 0; ks < 4; ++ks) { const int c0 = colin + 16 * ks + 8 * hh; const f32x4 m0 = *(const f32x4*)(mu + c0), m1 = *(const f32x4*)(mu + c0 + 4);
                    const unsigned ua[4] = {lx[ks][0].x, lx[ks][0].y, lx[ks][0].z, lx[ks][0].w}, up[4] = {lx[ks][1].x, lx[ks][1].y, lx[ks][1].z, lx[ks][1].w}, un[4] = {lx[ks][2].x, lx[ks][2].y, lx[ks][2].z, lx[ks][2].w};
                    float x[8];
#pragma unroll
                    for (int e = 0; e < 4; ++e) { const float x0 = bflo(ua[e]), x1 = bfhi(ua[e]), p0 = hp ? bflo(up[e]) : 0.f, p1 = hp ? bfhi(up[e]) : 0.f, n0 = hn ? bflo(un[e]) : 0.f, n1 = hn ? bfhi(un[e]) : 0.f;
                        const float mm0 = e < 2 ? m0[2 * e] : m1[2 * e - 4], mm1 = e < 2 ? m0[2 * e + 1] : m1[2 * e - 3];
                        x[2 * e] = x0 + mm0 * (0.5f * (p0 + n0) - x0); x[2 * e + 1] = x1 + mm1 * (0.5f * (p1 + n1) - x1); }
                    if (!which) {
#pragma unroll
                        for (int e = 0; e < 8; ++e) x[e] = 1.0f - 2.0f * __builtin_amdgcn_rcpf(1.0f + __expf(2.0f * x[e])); }
                    v4u w; w.x = pk2(x[0], x[1]); w.y = pk2(x[2], x[3]); w.z = pk2(x[4], x[5]); w.w = pk2(x[6], x[7]); bfr[ks] = __builtin_bit_cast(bf16x8, w); }
#pragma unroll
                for (int tl = 0; tl < 2; ++tl) { f32x16 acc;
#pragma unroll
                    for (int e = 0; e < 16; ++e) acc[e] = 0.f;
#pragma unroll
                    for (int ks = 0; ks < 4; ++ks) { const bf16x8 af = *(const bf16x8*)(wT + (size_t)(32 * tl + r32) * 64 + 16 * ks + 8 * hh); acc = MFMA32(af, bfr[ks], acc); }
                    LAS float* dst = (which ? LA : LW) + r32 * 64 + 32 * tl + 4 * hh;
#pragma unroll
                    for (int eg = 0; eg < 4; ++eg) { f32x4 o; o[0] = acc[4 * eg]; o[1] = acc[4 * eg + 1]; o[2] = acc[4 * eg + 2]; o[3] = acc[4 * eg + 3]; *(LAS f32x4*)(dst + 8 * eg) = o; } }
            }
            float r4[4], k4[4], v4[4], kk4[4];
#pragma unroll
            for (int jj = 0; jj < 4; ++jj) { const int t = t0 + 4 * B.wave + jj; const bool hp = t > 0, hn = t < T - 1;
                const float r0 = bf2f((bf16)pu[jj + 1][0]), k0 = bf2f((bf16)pu[jj + 1][1]), v0 = bf2f((bf16)pu[jj + 1][2]);
                const float rp = hp ? bf2f((bf16)pu[jj][0]) : 0.f, kp = hp ? bf2f((bf16)pu[jj][1]) : 0.f, vp = hp ? bf2f((bf16)pu[jj][2]) : 0.f;
                const float rn = hn ? bf2f((bf16)pu[jj + 2][0]) : 0.f, kn = hn ? bf2f((bf16)pu[jj + 2][1]) : 0.f, vn = hn ? bf2f((bf16)pu[jj + 2][2]) : 0.f;
                r4[jj] = r0 + mur * (0.5f * (rp + rn) - r0); k4[jj] = k0 + muk * (0.5f * (kp + kn) - k0); v4[jj] = v0 + muv * (0.5f * (vp + vn) - v0);
                const float kkr = k4[jj] * kkv, n2 = wave_sum(kkr * kkr); kk4[jj] = kkr / fmaxf(sqrtf(n2), 1e-12f); }
            __syncthreads();
#pragma unroll
            for (int jj = 0; jj < 4; ++jj) { const int j = 4 * B.wave + jj;
                const float wl = w0v + (DBG_NOLW ? 0.f : LW[j * 64 + lane]), w = __expf(-0.60653066f * sigmoid_f(wl)), aa = sigmoid_f(a0v + (DBG_NOLA ? 0.f : LA[j * 64 + lane]));
                LAS float* op = OPS + j * 320 + (lane & 15) * 4 + (lane >> 4);
                op[0] = kk4[jj]; op[64] = w; op[128] = kk4[jj] * aa; op[192] = k4[jj] * (1.0f + (aa - 1.0f) * kav); op[256] = r4[jj]; VV[j * 64 + lane] = v4[jj]; }
            __syncthreads();
            if (sg + 1 < 72) RW_PREFETCH(sg + 1);
            { const int g = lane >> 4, c16 = lane & 15; const LAS float* opb = OPS + c16 * 4; const LAS float* vvb = VV + 8 * B.wave + 2 * g; const int jstep = dir ? -1 : 1; int j = dir ? 31 : 0;
              f32x4 kk = *(const LAS f32x4*)(opb + j * 320), w = *(const LAS f32x4*)(opb + j * 320 + 64), kka = *(const LAS f32x4*)(opb + j * 320 + 128), kt = *(const LAS f32x4*)(opb + j * 320 + 192), rr = *(const LAS f32x4*)(opb + j * 320 + 256);
              f32x2 vv = *(const LAS f32x2*)(vvb + j * 64);
              for (int jj = 0; jj < 32; ++jj) {
                const int jn = jj < 31 ? j + jstep : j;
                const f32x4 kk_n = *(const LAS f32x4*)(opb + jn * 320), w_n = *(const LAS f32x4*)(opb + jn * 320 + 64), kka_n = *(const LAS f32x4*)(opb + jn * 320 + 128), kt_n = *(const LAS f32x4*)(opb + jn * 320 + 192), rr_n = *(const LAS f32x4*)(opb + jn * 320 + 256);
                const f32x2 vv_n = *(const LAS f32x2*)(vvb + jn * 64);
                float p0 = (S[0] * kk[0] + S[1] * kk[1]) + (S[2] * kk[2] + S[3] * kk[3]), p1 = (S[4] * kk[0] + S[5] * kk[1]) + (S[6] * kk[2] + S[7] * kk[3]);
                const float sk0 = row16_sum(p0), sk1 = row16_sum(p1);
#pragma unroll
                for (int q = 0; q < 4; ++q) { S[q] = S[q] * w[q] - sk0 * kka[q] + vv[0] * kt[q]; S[4 + q] = S[4 + q] * w[q] - sk1 * kka[q] + vv[1] * kt[q]; }
                float q0 = (S[0] * rr[0] + S[1] * rr[1]) + (S[2] * rr[2] + S[3] * rr[3]), q1 = (S[4] * rr[0] + S[5] * rr[1]) + (S[6] * rr[2] + S[7] * rr[3]);
                q0 = row16_sum(q0); q1 = row16_sum(q1);
                if (c16 == 0) { const size_t row = rowbase + t0 + j; const int ch = h * 64 + 8 * B.wave + 2 * g; f32x2 o2; o2[0] = q0; o2[1] = q1; *(f32x2*)(Y + ((size_t)dir * M_ALL + row) * 512 + ch) = o2; }
                kk = kk_n; w = w_n; kka = kka_n; kt = kt_n; rr = rr_n; vv = vv_n; j = jn;
              } }
        }
#undef RW_PREFETCH
    }
}
#undef RW_GEOM
__device__ __forceinline__ v2u ldg8(const void* base, unsigned boff) { return *(const v2u*)((const char*)base + boff); }
__device__ __forceinline__ f32x4 ldg16f(const void* base, unsigned boff) { return *(const f32x4*)((const char*)base + boff); }
__device__ __forceinline__ void ush4o(const bf16* UA, unsigned boff, bool hp, bool hn, const f32x4 m0_, float (&o)[4]) { const f32x4 m0 = m0_ * DBG_MUS;
    const v2u u0 = ldg8(UA, boff); v2u up = ldg8(UA, hp ? boff - UA_LD * 2 : boff), un = ldg8(UA, hn ? boff + UA_LD * 2 : boff);
    if (!hp) { up.x = 0; up.y = 0; } if (!hn) { un.x = 0; un.y = 0; }
    o[0] = bflo(u0.x) + m0[0] * (0.5f * (bflo(up.x) + bflo(un.x)) - bflo(u0.x)); o[1] = bfhi(u0.x) + m0[1] * (0.5f * (bfhi(up.x) + bfhi(un.x)) - bfhi(u0.x));
    o[2] = bflo(u0.y) + m0[2] * (0.5f * (bflo(up.y) + bflo(un.y)) - bflo(u0.y)); o[3] = bfhi(u0.y) + m0[3] * (0.5f * (bfhi(up.y) + bfhi(un.y)) - bfhi(u0.y));
}
__device__ __forceinline__ void rwkv_post_phase(const Args& a, const Blk& B) {
    const bf16* UA = (const bf16*)(a.ws + WS_R2); const float* Y = (const float*)(a.ws + WS_Y); const bf16* g2T = (const bf16*)(a.ws + WS_LORA) + 2 * 65536; bf16* YM = (bf16*)(a.ws + WS_H);
    const float* mu = a.in[I_MU]; const float* RK = a.in[I_RK]; const float* GNG = a.in[I_GNG]; const float* GNB = a.in[I_GNB];
    const int gw = B.bid * NWAVES + B.wave, NGW = B.G * NWAVES, r32 = B.lane & 31, hh = B.lane >> 5;
#pragma unroll 1
    for (int tile = gw; tile < M_ALL / 32; tile += NGW) {
        const unsigned row = (unsigned)tile * 32 + r32; const bool isctx = row >= (unsigned)M_LAT; const int t = isctx ? (int)((row - M_LAT) & (CTXL - 1)) : (int)(row & (SEQ - 1)), T = isctx ? CTXL : SEQ;
        const bool hp = t > 0, hn = t < T - 1;
        bf16x8 bg[8];
#pragma unroll
        for (int ks = 0; ks < 8; ++ks) { float x[8]; ush8(UA, row, 1792 + 16 * ks + 8 * hh, hp, hn, mu, x);
            v4u w; w.x = pk2(sigmoid_f(x[0]), sigmoid_f(x[1])); w.y = pk2(sigmoid_f(x[2]), sigmoid_f(x[3])); w.z = pk2(sigmoid_f(x[4]), sigmoid_f(x[5])); w.w = pk2(sigmoid_f(x[6]), sigmoid_f(x[7])); bg[ks] = __builtin_bit_cast(bf16x8, w); }
#pragma unroll 1
        for (int hd = 0; hd < 8; ++hd) {
            const unsigned chb = 64 * hd + 4 * hh;
            const unsigned uo = row * (UA_LD * 2) + chb * 2, yo = row * 2048 + chb * 4, po = chb * 4;
            float y[32], rkp = 0.f, ys = 0.f;
#pragma unroll
            for (int q = 0; q < 8; ++q) { const unsigned co = 32 * (q >> 2) + 8 * (q & 3);
                const f32x4 yf = ldg16f(Y, yo + co * 4), yb = ldg16f(Y + (size_t)M_ALL * 512, yo + co * 4);
                { const float cf = DBG_NOYF ? 0.f : 1.f, cb = DBG_NOYB ? 0.f : 1.f; y[4 * q] = cf * yf[0] + cb * yb[0]; y[4 * q + 1] = cf * yf[1] + cb * yb[1]; y[4 * q + 2] = cf * yf[2] + cb * yb[2]; y[4 * q + 3] = cf * yf[3] + cb * yb[3]; }
                ys += (y[4 * q] + y[4 * q + 1]) + (y[4 * q + 2] + y[4 * q + 3]);
                float rr[4], kk[4]; ush4o(UA, uo + co * 2, hp, hn, ldg16f(mu, po + co * 4), rr); ush4o(UA, uo + (512 + co) * 2, hp, hn, ldg16f(mu + 512, po + co * 4), kk); const f32x4 rk = ldg16f(RK, po + co * 4);
                rkp += rr[0] * kk[0] * rk[0] + rr[1] * kk[1] * rk[1] + rr[2] * kk[2] * rk[2] + rr[3] * kk[3] * rk[3]; }
            const float mean = xhalf_sum(ys) * (1.0f / 64.0f); float q2 = 0.f;
#pragma unroll
            for (int e = 0; e < 32; ++e) { y[e] -= mean; q2 += y[e] * y[e]; }
            const float rstd = 1.0f / sqrtf(xhalf_sum(q2) * (1.0f / 64.0f) + GN_EPS), rks = DBG_NOBONUS ? 0.f : xhalf_sum(rkp);
#pragma unroll
            for (int tl = 0; tl < 2; ++tl) {
                f32x16 g0;
#pragma unroll
                for (int e = 0; e < 16; ++e) g0[e] = 0.f;
#pragma unroll
                for (int ks = 0; ks < 8; ++ks) { const bf16x8 a0 = *(const bf16x8*)((const char*)g2T + (unsigned)(((64 * hd + 32 * tl + r32) * 128 + 16 * ks + 8 * hh) * 2)); g0 = MFMA32(a0, bg[ks], g0); }
#pragma unroll
                for (int eg = 0; eg < 4; ++eg) { const unsigned co = 32 * tl + 8 * eg; float vv[4]; ush4o(UA, uo + (1024 + co) * 2, hp, hn, ldg16f(mu + 1024, po + co * 4), vv);
                    const f32x4 gg = ldg16f(GNG, po + co * 4), gb = ldg16f(GNB, po + co * 4); float o[4];
#pragma unroll
                    for (int e = 0; e < 4; ++e) o[e] = (DBG_Z_RWKV || DBG_HZ_RWKV(hd)) ? 0.f : DBG_S_RWKV * (y[16 * tl + 4 * eg + e] * rstd * gg[e] + gb[e] + rks * vv[e]) * g0[4 * eg + e];
                    v2u w; w.x = pk2(o[0], o[1]); w.y = pk2(o[2], o[3]); *(v2u*)((char*)YM + (row * 2048u + (chb + co) * 2)) = w; }
            }
        }
    }
}

__device__ __forceinline__ void rope_phase(const Args& a, const Blk& B) {
    bf16* U1 = (bf16*)(a.ws + WS_R2); const int gw = B.bid * NWAVES + B.wave, NGW = B.G * NWAVES;
    const int i = B.lane & 15, seg = (B.lane >> 4) & 1, vpar = B.lane >> 5; const float freq = powf(10000.0f, -(float)i * (1.0f / 16.0f));
    for (int row = gw; row < M_LAT; row += NGW) {
        const int t = row & (SEQ - 1), pos = (DBG_ROPE == 2 ? !seg : seg) ? (t & 63) : (t >> 6); float sn, cs; sincosf((float)pos * freq * (DBG_ROPE == 3 ? -1.f : 1.f), &sn, &cs); if (DBG_ROPE == 1) { sn = 0.f; cs = 1.f; }
        bf16* ur = U1 + (size_t)row * U1_LD;
#pragma unroll
        for (int it = 0; it < 8; ++it) { const int v = 2 * it + vpar, c0 = (v < 8 ? 1568 + v * 64 : 2080 + (v - 8) * 64) + 32 * seg + i;
            const float x1 = bf2f(ur[c0]), x2 = bf2f(ur[c0 + 16]); ur[c0] = f2bf(x1 * cs - x2 * sn); ur[c0 + 16] = f2bf(x2 * cs + x1 * sn); }
    }
}

constexpr int DK_P = 136, DV_P = 36;
constexpr int DF_K0 = 0, DF_K1 = 32 * DK_P * 2, DF_V0 = 2 * 32 * DK_P * 2, DF_V1 = DF_V0 + 128 * DV_P * 2, DF_Q = DF_V1 + 128 * DV_P * 2;
__device__ __forceinline__ void diff_block(const Args& a, const Blk& B, int b, int hd, int qblk, float lam) {
    const bf16* U1 = (const bf16*)(a.ws + WS_R2); const bf16* VT = (const bf16*)(a.ws + WS_VT1); bf16* YM = (bf16*)(a.ws + WS_H);
    const int r32 = B.lane & 31, hh = B.lane >> 5; const size_t qrow = (size_t)b * SEQ + (qblk * 8 + B.wave) * 32 + r32;
    LAS bf16* Qs = (LAS bf16*)(B.lds + DF_Q + B.wave * (32 * DK_P * 2));
#pragma unroll
    for (int c = 0; c < 8; ++c) *(LAS v4u*)(Qs + r32 * DK_P + 16 * c + 8 * hh) = *(const v4u*)(U1 + qrow * U1_LD + 1568 + hd * 128 + 16 * c + 8 * hh);
    f32x16 Oa[4], Ob[4];
#pragma unroll
    for (int d = 0; d < 4; ++d)
#pragma unroll
        for (int e = 0; e < 16; ++e) { Oa[d][e] = 0.f; Ob[d][e] = 0.f; }
    float m0 = -1e30f, l0 = 0.f, m1 = -1e30f, l1 = 0.f;
    const int skey = B.tid >> 4, skc = B.tid & 15, sdv = B.tid >> 2, svc = B.tid & 3;
    const bf16* vsrc = VT + ((size_t)(b * 4 + hd) * 128 + sdv) * NKEY + 8 * svc;
    const unsigned kdst = (unsigned)(skey * DK_P + 8 * skc) * 2u, vdst = (unsigned)(sdv * DV_P + 8 * svc) * 2u;
    v4u kreg, vreg;
#define DF_LOAD(kt) do { const int ki_ = 32 * (kt) + skey; const size_t kr_ = ki_ < SEQ ? (size_t)b * SEQ + ki_ : (size_t)M_LAT + b * CTXL + (ki_ - SEQ); \
        kreg = *(const v4u*)(U1 + kr_ * U1_LD + 2080 + hd * 128 + 8 * skc); vreg = *(const v4u*)(vsrc + 32 * (kt)); } while (0)
#define DF_STORE(buf) do { *(LAS v4u*)(B.lds + ((buf) ? DF_K1 : DF_K0) + kdst) = kreg; const LAS unsigned char* vb_ = B.lds + ((buf) ? DF_V1 : DF_V0) + vdst; \
        *(LAS v2u*)vb_ = (v2u){vreg.x, vreg.y}; *(LAS v2u*)(vb_ + 8) = (v2u){vreg.z, vreg.w}; } while (0)
    DF_LOAD(0); DF_STORE(0);
    __syncthreads();
    for (int kt = 0; kt < NKEY / 32; ++kt) {
        if (kt + 1 < NKEY / 32) DF_LOAD(kt + 1);
        const LAS bf16* Ks = (const LAS bf16*)(B.lds + ((kt & 1) ? DF_K1 : DF_K0)); const LAS bf16* Vs = (const LAS bf16*)(B.lds + ((kt & 1) ? DF_V1 : DF_V0));
        f32x16 s; float al0, al1; bf16x8 pa0, pa1, pb0, pb1;
#pragma unroll
        for (int e = 0; e < 16; ++e) s[e] = 0.f;
#pragma unroll
        for (int ks = 0; ks < 4; ++ks) { const bf16x8 kf = *(const LAS bf16x8*)(Ks + r32 * DK_P + 16 * ks + 8 * hh), qf = *(const LAS bf16x8*)(Qs + r32 * DK_P + 16 * ks + 8 * hh); s = MFMA32(kf, qf, s); }
        sm_update(s, m0, l0, al0, pa0, pa1);
#pragma unroll
        for (int e = 0; e < 16; ++e) s[e] = 0.f;
#pragma unroll
        for (int ks = 0; ks < 4; ++ks) { const bf16x8 kf = *(const LAS bf16x8*)(Ks + r32 * DK_P + 64 + 16 * ks + 8 * hh), qf = *(const LAS bf16x8*)(Qs + r32 * DK_P + 64 + 16 * ks + 8 * hh); s = MFMA32(kf, qf, s); }
        sm_update(s, m1, l1, al1, pb0, pb1);
#pragma unroll
        for (int d = 0; d < 4; ++d) {
#pragma unroll
            for (int e = 0; e < 16; ++e) { Oa[d][e] *= al0; Ob[d][e] *= al1; }
            const LAS bf16* vr = Vs + (32 * d + r32) * DV_P + 4 * hh;
            const v2u a0 = *(const LAS v2u*)(vr), a1 = *(const LAS v2u*)(vr + 8), a2 = *(const LAS v2u*)(vr + 16), a3 = *(const LAS v2u*)(vr + 24);
            const bf16x8 v0 = __builtin_bit_cast(bf16x8, ((v4u){a0.x, a0.y, a1.x, a1.y})), v1 = __builtin_bit_cast(bf16x8, ((v4u){a2.x, a2.y, a3.x, a3.y}));
            Oa[d] = MFMA32(v0, pa0, Oa[d]); Oa[d] = MFMA32(v1, pa1, Oa[d]); Ob[d] = MFMA32(v0, pb0, Ob[d]); Ob[d] = MFMA32(v1, pb1, Ob[d]); }
        if (kt + 1 < NKEY / 32) DF_STORE((kt + 1) & 1);
        __syncthreads();
    }
#undef DF_LOAD
#undef DF_STORE
    const float i0 = 1.0f / xhalf_sum(l0), i1 = (DBG_DIFF_LAM0 ? 0.f : lam) / xhalf_sum(l1); float ss = 0.f;
#pragma unroll
    for (int d = 0; d < 4; ++d)
#pragma unroll
        for (int e = 0; e < 16; ++e) { const float o = Oa[d][e] * i0 - Ob[d][e] * i1; Oa[d][e] = o; ss += o * o; }
    const float rms = (DBG_Z_DIFF || DBG_HZ_DIFF(hd)) ? 0.f : DBG_S_DIFF / sqrtf(xhalf_sum(ss) * (1.0f / 128.0f) + RMS_EPS) * (1.0f - LAMBDA_INIT);
    bf16* yo = YM + qrow * D + 512 + hd * 128 + 4 * hh; const float* ng = a.in[I_DNG] + 4 * hh;
#pragma unroll
    for (int d = 0; d < 4; ++d)
#pragma unroll
        for (int eg = 0; eg < 4; ++eg) { const f32x4 g = *(const f32x4*)(ng + 32 * d + 8 * eg);
            v2u o; o.x = pk2(Oa[d][4 * eg] * rms * g[0], Oa[d][4 * eg + 1] * rms * g[1]); o.y = pk2(Oa[d][4 * eg + 2] * rms * g[2], Oa[d][4 * eg + 3] * rms * g[3]); *(v2u*)(yo + 32 * d + 8 * eg) = o; }
}

constexpr int GP = 72;
constexpr int GL_G = 0, GL_BL = 16384, GL_BR = 16640, GL_QD = 16896, GL_KD = GL_QD + 64 * GP * 2, GL_QS = GL_KD + 64 * GP * 2, GL_KE = GL_QS + 64 * GP * 2, GL_AM = GL_KE + 64 * GP * 2, GL_VT = GL_AM + 64 * GP * 2, GL_ST = GL_VT + 128 * GP * 2, GL_END = GL_ST + 128 * GP * 2;
__device__ __forceinline__ float logsig(float x) { return fminf(x, 0.f) - log1pf(__expf(-fabsf(x))); }
__device__ __forceinline__ void gla_scan(const Args& a, const Blk& B, int scan) {
    const bf16* U1 = (const bf16*)(a.ws + WS_R2); bf16* YM = (bf16*)(a.ws + WS_H); bf16* GOB = (bf16*)(a.ws + WS_GOB);
    const int dir = scan & 1, h = (scan >> 1) & 3, b = scan >> 3, lane = B.lane, r32 = lane & 31, hh = lane >> 5, w = B.wave;
    LAS float* G = (LAS float*)(B.lds + GL_G); LAS float* BL = (LAS float*)(B.lds + GL_BL); LAS float* BR = (LAS float*)(B.lds + GL_BR);
    LAS bf16* QD = (LAS bf16*)(B.lds + GL_QD); LAS bf16* KD = (LAS bf16*)(B.lds + GL_KD); LAS bf16* QS = (LAS bf16*)(B.lds + GL_QS); LAS bf16* KE = (LAS bf16*)(B.lds + GL_KE);
    LAS bf16* AM = (LAS bf16*)(B.lds + GL_AM); LAS bf16* VTL = (LAS bf16*)(B.lds + GL_VT); LAS bf16* STL = (LAS bf16*)(B.lds + GL_ST);
    float g2c[16];
#pragma unroll
    for (int j = 0; j < 16; ++j) g2c[j] = a.in[I_GLAG2][(size_t)(dir * 16 + j) * 256 + h * 64 + lane];
    const float gbv = a.in[I_GLAGB][dir * 256 + h * 64 + lane];
    f32x16 Sacc;
#pragma unroll
    for (int e = 0; e < 16; ++e) Sacc[e] = 0.f;
    for (int i = B.tid; i < 128 * GP / 2; i += 512) ((LAS unsigned*)STL)[i] = 0u;
    __syncthreads();
    for (int cc = 0; cc < 36; ++cc) {
        const bool isctx = cc < 4; const int ci = isctx ? (dir ? 3 - cc : cc) : (dir ? 35 - cc : cc - 4);
        const size_t row0 = isctx ? (size_t)M_LAT + b * CTXL + ci * 64 : (size_t)b * SEQ + ci * 64;
#if DBG_CHECKS
        if (scan == 18 && cc == 4) { float* dq = (float*)(a.ws + WS_CTL) + 65536; for (int i = B.tid; i < 8192; i += 512) dq[4096 + i] = bf2f(STL[(i >> 6) * GP + (i & 63)]); }
#endif
#pragma unroll
        for (int q = 0; q < 8; ++q) { const int tau = 8 * w + q; const bf16* gp = U1 + (row0 + tau) * U1_LD + 1536 + 16 * dir; const v4u g0 = *(const v4u*)gp, g1 = *(const v4u*)(gp + 8);
            const unsigned gw[8] = {g0.x, g0.y, g0.z, g0.w, g1.x, g1.y, g1.z, g1.w}; float s = gbv;
#pragma unroll
            for (int j = 0; j < 8; ++j) s += DBG_GLA_NOGD ? 0.f : (bflo(gw[j]) * g2c[2 * j] + bfhi(gw[j]) * g2c[2 * j + 1]);
            G[tau * 64 + lane] = logsig(s) * (1.0f / 16.0f); }
        __syncthreads();
        if (w == 0) { float acc = 0.f;
            if (!dir) { for (int tau = 0; tau < 64; ++tau) { acc += G[tau * 64 + lane]; G[tau * 64 + lane] = acc; if (tau == 31) BR[lane] = acc; } }
            else { for (int tau = 63; tau >= 0; --tau) { acc += G[tau * 64 + lane]; G[tau * 64 + lane] = acc; if (tau == 32) BR[lane] = acc; } }
            BL[lane] = acc; }
        __syncthreads();
        { const int tau = B.tid >> 3, k0 = (B.tid & 7) * 8; const bf16* ur = U1 + (row0 + tau) * U1_LD;
          const v4u qv = *(const v4u*)(ur + h * 64 + k0), kv = *(const v4u*)(ur + 256 + h * 64 + k0);
          const unsigned qw[4] = {qv.x, qv.y, qv.z, qv.w}, kw[4] = {kv.x, kv.y, kv.z, kv.w};
          float qd[8], kd[8], qs[8], ke[8];
#pragma unroll
          for (int e = 0; e < 8; ++e) { const float bc = G[tau * 64 + k0 + e], br = BR[k0 + e], bl = BL[k0 + e];
              const float qq = (e & 1) ? bfhi(qw[e >> 1]) : bflo(qw[e >> 1]), kk = (e & 1) ? bfhi(kw[e >> 1]) : bflo(kw[e >> 1]);
              qd[e] = qq * __expf(bc - br); kd[e] = kk * __expf(br - bc); qs[e] = qq * __expf(bc); ke[e] = kk * __expf(bl - bc); }
          v4u o; o.x = pk2s(qd[0], qd[1]); o.y = pk2s(qd[2], qd[3]); o.z = pk2s(qd[4], qd[5]); o.w = pk2s(qd[6], qd[7]); *(LAS v4u*)(QD + tau * GP + k0) = o;
          o.x = pk2s(kd[0], kd[1]); o.y = pk2s(kd[2], kd[3]); o.z = pk2s(kd[4], kd[5]); o.w = pk2s(kd[6], kd[7]); *(LAS v4u*)(KD + tau * GP + k0) = o;
          o.x = pk2s(qs[0], qs[1]); o.y = pk2s(qs[2], qs[3]); o.z = pk2s(qs[4], qs[5]); o.w = pk2s(qs[6], qs[7]); *(LAS v4u*)(QS + tau * GP + k0) = o;
#pragma unroll
          for (int e = 0; e < 8; ++e) KE[(k0 + e) * GP + tau] = f2bfs(ke[e]);
          const int d0 = (B.tid & 7) * 16; const v4u va = *(const v4u*)(ur + 512 + h * 128 + d0), vb = *(const v4u*)(ur + 512 + h * 128 + d0 + 8);
          const unsigned vw[8] = {va.x, va.y, va.z, va.w, vb.x, vb.y, vb.z, vb.w};
#pragma unroll
          for (int e = 0; e < 8; ++e) { VTL[(d0 + 2 * e) * GP + tau] = (bf16)(vw[e] & 0xffffu); VTL[(d0 + 2 * e + 1) * GP + tau] = (bf16)(vw[e] >> 16); } }
        __syncthreads();
        f32x16 Oacc;
        const int dvt = w >> 1, tt = w & 1;
        if (!isctx) {
#pragma unroll
            for (int e = 0; e < 16; ++e) Oacc[e] = 0.f;
#pragma unroll
            for (int ks = 0; ks < 4; ++ks) { const bf16x8 af = *(const LAS bf16x8*)(STL + (32 * dvt + r32) * GP + 16 * ks + 8 * hh), bfr = *(const LAS bf16x8*)(QS + (32 * tt + r32) * GP + 16 * ks + 8 * hh); Oacc = MFMA32(af, bfr, Oacc); }
#if DBG_CHECKS
            if (scan == 18 && cc == 4) { float* dq = (float*)(a.ws + WS_CTL) + 65536; for (int i = B.tid; i < 4096; i += 512) dq[i] = bf2f(QS[(i >> 6) * GP + (i & 63)]); }
            if (scan == 18 && cc == 4) { float* dbg = (float*)(a.ws + WS_CTL) + 32768; for (int e = 0; e < 16; ++e) dbg[(32 * tt + r32) * 128 + 32 * dvt + (e & 3) + 8 * (e >> 2) + 4 * hh] = Oacc[e]; }
#endif
            if (w < 4) { const int st = w & 1, t2 = w >> 1; f32x16 am;
#pragma unroll
                for (int e = 0; e < 16; ++e) am[e] = 0.f;
#pragma unroll
                for (int ks = 0; ks < 4; ++ks) { const bf16x8 af = *(const LAS bf16x8*)(KD + (32 * st + r32) * GP + 16 * ks + 8 * hh), bfr = *(const LAS bf16x8*)(QD + (32 * t2 + r32) * GP + 16 * ks + 8 * hh); am = MFMA32(af, bfr, am); }
                const int t = 32 * t2 + r32;
#pragma unroll
                for (int eg = 0; eg < 4; ++eg) { float o[4];
#pragma unroll
                    for (int e = 0; e < 4; ++e) { const int s = 32 * st + 8 * eg + 4 * hh + e; const bool ok = dir ? (s >= t) : (s <= t); o[e] = ok ? am[4 * eg + e] : 0.f; }
                    v2u pw; pw.x = pk2s(o[0], o[1]); pw.y = pk2s(o[2], o[3]); *(LAS v2u*)(AM + t * GP + 32 * st + 8 * eg + 4 * hh) = pw; } }
        }
        __syncthreads();
        if (!isctx) {
#pragma unroll
            for (int ks = 0; ks < 4; ++ks) { const bf16x8 af = *(const LAS bf16x8*)(VTL + (32 * dvt + r32) * GP + 16 * ks + 8 * hh), bfr = *(const LAS bf16x8*)(AM + (32 * tt + r32) * GP + 16 * ks + 8 * hh); Oacc = MFMA32(af, bfr, Oacc); }
#if DBG_CHECKS
            if (scan == 18 && cc == 4) { float* dbg = (float*)(a.ws + WS_CTL) + 32768 + 8192; for (int e = 0; e < 16; ++e) dbg[(32 * tt + r32) * 128 + 32 * dvt + (e & 3) + 8 * (e >> 2) + 4 * hh] = Oacc[e]; }
#endif
            bf16* orow = (dir ? GOB + (row0 + 32 * tt + r32) * 512 : YM + (row0 + 32 * tt + r32) * D) + h * 128 + 32 * dvt + 4 * hh;
#pragma unroll
            for (int eg = 0; eg < 4; ++eg) { v2u o; o.x = pk2s(Oacc[4 * eg], Oacc[4 * eg + 1]); o.y = pk2s(Oacc[4 * eg + 2], Oacc[4 * eg + 3]); *(v2u*)(orow + 8 * eg) = o; }
        }
        { const int kt = w & 1; const float dec = __expf(BL[32 * kt + r32]);
#pragma unroll
          for (int e = 0; e < 16; ++e) Sacc[e] *= dec;
#pragma unroll
          for (int ks = 0; ks < 4; ++ks) { const bf16x8 af = *(const LAS bf16x8*)(VTL + (32 * dvt + r32) * GP + 16 * ks + 8 * hh), bfr = *(const LAS bf16x8*)(KE + (32 * kt + r32) * GP + 16 * ks + 8 * hh); Sacc = MFMA32(af, bfr, Sacc); }
        }
        { const int kt = w & 1;
#pragma unroll
          for (int e = 0; e < 16; ++e) STL[(32 * dvt + (e & 3) + 8 * (e >> 2) + 4 * hh) * GP + 32 * kt + r32] = f2bfs(Sacc[e]);
#if DBG_CHECKS
          if (scan == 18 && cc == 3) { float* dbg = (float*)(a.ws + WS_CTL) + 24576; for (int e = 0; e < 16; ++e) dbg[(32 * dvt + (e & 3) + 8 * (e >> 2) + 4 * hh) * 64 + 32 * kt + r32] = Sacc[e]; }
#endif
          }
        __syncthreads();
    }
}
__device__ __forceinline__ void gla_post_phase(const Args& a, const Blk& B) {
    const bf16* U1 = (const bf16*)(a.ws + WS_R2); bf16* YM = (bf16*)(a.ws + WS_H); const bf16* GOB = (const bf16*)(a.ws + WS_GOB);
    const int gw = B.bid * NWAVES + B.wave, NGW = B.G * NWAVES, c0 = 8 * B.lane;
    const f32x4 n0 = *(const f32x4*)(a.in[I_GLANG] + (c0 & 127)), n1 = *(const f32x4*)(a.in[I_GLANG] + (c0 & 127) + 4);
    for (int row = gw; row < M_LAT; row += NGW) {
        const v4u of = *(const v4u*)(YM + (size_t)row * D + c0), ob = *(const v4u*)(GOB + (size_t)row * 512 + c0), rv = *(const v4u*)(U1 + (size_t)row * U1_LD + 1024 + c0);
        const unsigned fw[4] = {of.x, of.y, of.z, of.w}, bw[4] = {ob.x, ob.y, ob.z, ob.w}, rw[4] = {rv.x, rv.y, rv.z, rv.w};
        float o[8], ss = 0.f;
#pragma unroll
        for (int e = 0; e < 4; ++e) { { const float cf = DBG_GLA_NOF ? 0.f : 1.f, cb = DBG_GLA_NOB ? 0.f : 1.f; o[2 * e] = cf * bflo(fw[e]) + cb * bflo(bw[e]); o[2 * e + 1] = cf * bfhi(fw[e]) + cb * bfhi(bw[e]); } ss += o[2 * e] * o[2 * e] + o[2 * e + 1] * o[2 * e + 1]; }
        const float rms = (DBG_Z_GLA || DBG_HZ_GLA(B.lane >> 4)) ? 0.f : DBG_S_GLA / sqrtf(row16_sum(ss) * (1.0f / 128.0f) + RMS_EPS);
        float y[8];
#pragma unroll
        for (int e = 0; e < 8; ++e) { const float r = (e & 1) ? bfhi(rw[e >> 1]) : bflo(rw[e >> 1]); const float ng = e < 4 ? n0[e] : n1[e - 4]; y[e] = o[e] * rms * ng * (r * sigmoid_f(r)); }
        v4u w; w.x = pk2(y[0], y[1]); w.y = pk2(y[2], y[3]); w.z = pk2(y[4], y[5]); w.w = pk2(y[6], y[7]); *(v4u*)(YM + (size_t)row * D + c0) = w;
    }
}

#ifndef DBG_CHECKS
#define DBG_CHECKS 0
#endif
#ifndef DBG_MSHIFT
#define DBG_MSHIFT 0
#endif
#ifndef DBG_QSCHK
#define DBG_QSCHK 0
#endif
#ifndef DBG_GLADIR
#define DBG_GLADIR 0
#endif
#if DBG_CHECKS
constexpr int CW_CHK = 20480;
constexpr int CW_SAVE = 24576;
__device__ __forceinline__ void chk_fail(unsigned* ctl, unsigned code) { unsigned e = 0u; __hip_atomic_compare_exchange_strong(ctl + CW_CHK, &e, code, __ATOMIC_RELAXED, __ATOMIC_RELAXED, __HIP_MEMORY_SCOPE_AGENT); }
__device__ __forceinline__ bool chk_close(float got, float ref, float scale) { return fabsf(got - ref) <= 0.02f * scale + 0.003f; }
__device__ __forceinline__ float wmax(float v) { for (int o = 1; o < 64; o <<= 1) v = fmaxf(v, __shfl_xor(v, o)); return v; }
__device__ __forceinline__ float wsum(float v) { for (int o = 1; o < 64; o <<= 1) v += __shfl_xor(v, o); return v; }
__device__ __forceinline__ bool wany(bool b) { return __ballot(b) != 0ull; }

__device__ __forceinline__ void chk_na(const Args& a, unsigned* ctl, int lane) {
    const bf16* UB = (const bf16*)(a.ws + WS_R3); const bf16* YM = (const bf16*)(a.ws + WS_H); const float* rpb = a.in[I_RPB];
    const int smp[6][4] = {{0, 0, 0, 0}, {3, 5, 17, 40}, {15, 7, 31, 63}, {7, 2, 4, 31}, {9, 1, 27, 8}, {2, 3, -1, 100}};
#pragma unroll
    for (int si = 0; si < 6; ++si) { const int b = smp[si][0], h = smp[si][1], r = smp[si][2], c = smp[si][3]; const bool lat = r >= 0;
        const size_t qrow = lat ? (size_t)b * SEQ + r * 64 + c : (size_t)M_LAT + b * CTXL + c;
        float m = -1e30f;
        for (int pass = 0; pass < 2; ++pass) { float l = 0.f, o = 0.f;
            for (int j = 0; j < CTXL + (lat ? 128 : 0); ++j) { size_t krow; float bias = 0.f;
                if (j < CTXL) krow = (size_t)M_LAT + b * CTXL + j;
                else { const int jj = j - CTXL, i = jj >> 4, kc0 = jj & 15, rs = min(max(r - 4, 0), 24), cs = min(max(c - 8, 0), 48), kr = rs + i, kc = cs + kc0; krow = (size_t)b * SEQ + kr * 64 + kc; bias = rpb[(h * 15 + (kr - r + 7)) * 31 + (kc - c + 15)]; }
                float s = 0.f; for (int d = 0; d < 64; ++d) s += bf2f(UB[qrow * UB_LD + h * 64 + d]) * bf2f(UB[krow * UB_LD + 512 + h * 64 + d]);
                s += bias;
                if (pass == 0) m = fmaxf(m, s); else { const float p = expf(s - m); l += p; o += p * bf2f(UB[krow * UB_LD + 1024 + h * 64 + lane]); } }
            if (pass == 1) { const float ref = o / l, got = bf2f(YM[qrow * D + 512 + h * 64 + lane]); const float sc = wmax(fabsf(ref));
                if (wany(!chk_close(got, ref, sc))) { chk_fail(ctl, 7); return; } } }
    }
}
__device__ __forceinline__ void chk_rwkv_scan(const Args& a, unsigned* ctl, int lane, int b, int h, int dir, LAS float* sh) {
    const bf16* UA = (const bf16*)(a.ws + WS_R2); const float* Y = (const float*)(a.ws + WS_Y); const float* mu = a.in[I_MU];
    const int hc = h * 64 + lane; float S[64];
    _Pragma("unroll") for (int k = 0; k < 64; ++k) S[k] = 0.f;
    bool bad = false;
    for (int st = 0; st < CTXL + SEQ; ++st) { const bool isctx = st < CTXL; const int T = isctx ? CTXL : SEQ; const int tt = isctx ? st : st - CTXL, t = dir ? T - 1 - tt : tt;
        const size_t row = isctx ? (size_t)M_LAT + b * CTXL + t : (size_t)b * SEQ + t; const bool hp = t > 0, hn = t < T - 1;
        auto shf = [&](int col) { const float x0 = bf2f(UA[row * UA_LD + col]), xp = hp ? bf2f(UA[(row - 1) * UA_LD + col]) : 0.f, xn = hn ? bf2f(UA[(row + 1) * UA_LD + col]) : 0.f; return x0 + mu[col] * (0.5f * (xp + xn) - x0); };
        const float r_ = shf(hc), k_ = shf(512 + hc), v_ = shf(1024 + hc);
        float lw = 0.f, la = 0.f;
        for (int j = 0; j < 64; ++j) { lw += tanhf(shf(1536 + 64 * dir + j)) * a.in[I_W2][((size_t)dir * 64 + j) * 512 + hc]; la += shf(1664 + 64 * dir + j) * a.in[I_A2][((size_t)dir * 64 + j) * 512 + hc]; }
        const float wl = a.in[I_W0][dir * 512 + hc] + lw, w = expf(-expf(-log1pf(expf(-wl)) - 0.5f)), aa = 1.f / (1.f + expf(-(a.in[I_A0][dir * 512 + hc] + la)));
        const float kkr = k_ * a.in[I_KK][hc], kk = kkr / fmaxf(sqrtf(wsum(kkr * kkr)), 1e-12f), kt = k_ * (1.f + (aa - 1.f) * a.in[I_KA][hc]);
        sh[lane] = kk; sh[64 + lane] = w; sh[128 + lane] = kk * aa; sh[192 + lane] = kt; sh[256 + lane] = r_; __syncthreads();
        float sk = 0.f; _Pragma("unroll") for (int k = 0; k < 64; ++k) sk += S[k] * sh[k];
        float y = 0.f; _Pragma("unroll") for (int k = 0; k < 64; ++k) { S[k] = S[k] * sh[64 + k] - sk * sh[128 + k] + v_ * sh[192 + k]; y += S[k] * sh[256 + k]; }
        __syncthreads();
        if ((st & 127) == 5 || st == CTXL - 1 || st == CTXL || st == CTXL + SEQ - 1) { const float got = Y[((size_t)dir * M_ALL + row) * 512 + hc]; const float sc = wmax(fabsf(y)); if (wany(!chk_close(got, y, sc))) bad = true; }
    }
    if (bad) chk_fail(ctl, 8);
}
__device__ __forceinline__ void chk_rwkv_post(const Args& a, unsigned* ctl, int lane) {
    const bf16* UA = (const bf16*)(a.ws + WS_R2); const float* Y = (const float*)(a.ws + WS_Y); const bf16* YM = (const bf16*)(a.ws + WS_H); const float* mu = a.in[I_MU];
    const size_t rows[5] = {0, 2047, 12345, (size_t)M_LAT + 7, (size_t)M_ALL - 1};
#pragma unroll
    for (int si = 0; si < 5; ++si) { const size_t row = rows[si]; const bool isctx = row >= (size_t)M_LAT; const int T = isctx ? CTXL : SEQ, t = isctx ? (int)((row - M_LAT) % CTXL) : (int)(row % SEQ); const bool hp = t > 0, hn = t < T - 1;
        auto shf = [&](int col) { const float x0 = bf2f(UA[row * UA_LD + col]), xp = hp ? bf2f(UA[(row - 1) * UA_LD + col]) : 0.f, xn = hn ? bf2f(UA[(row + 1) * UA_LD + col]) : 0.f; return x0 + mu[col] * (0.5f * (xp + xn) - x0); };
        for (int hd = 0; hd < 8; hd += 3) { const int ch = hd * 64 + lane; const float y = Y[row * 512 + ch] + Y[((size_t)M_ALL + row) * 512 + ch];
            const float mean = wsum(y) / 64.f, var = wsum((y - mean) * (y - mean)) / 64.f; const float rk = wsum(shf(ch) * shf(512 + ch) * a.in[I_RK][ch]);
            float g = 0.f; for (int j = 0; j < 128; ++j) g += (1.f / (1.f + expf(-shf(1792 + j)))) * a.in[I_G2][(size_t)j * 512 + ch];
            const float ref = ((y - mean) / sqrtf(var + GN_EPS) * a.in[I_GNG][ch] + a.in[I_GNB][ch] + rk * shf(1024 + ch)) * g, got = bf2f(YM[row * D + ch]); const float sc = wmax(fabsf(ref));
            if (wany(!chk_close(got, ref, sc))) { chk_fail(ctl, 9); return; } } }
}
__device__ __forceinline__ void chk_diff(const Args& a, unsigned* ctl, int lane) {
    const bf16* U1 = (const bf16*)(a.ws + WS_R2); const bf16* YM = (const bf16*)(a.ws + WS_H);
    const float* lp = a.in[I_DLAM]; const float lam = expf(wsum(lp[lane] * lp[64 + lane])) - expf(wsum(lp[128 + lane] * lp[192 + lane])) + LAMBDA_INIT;
    const int smp[4][3] = {{0, 0, 0}, {5, 2, 1234}, {15, 3, 2047}, {8, 1, 64}};
#pragma unroll
    for (int si = 0; si < 4; ++si) { const int b = smp[si][0], hd = smp[si][1], t = smp[si][2]; const size_t qrow = (size_t)b * SEQ + t; float o0[2] = {0.f, 0.f}, o1[2] = {0.f, 0.f};
        for (int mm = 0; mm < 2; ++mm) { float m = -1e30f, l = 0.f, oa = 0.f, ob = 0.f;
            for (int pass = 0; pass < 2; ++pass)
                for (int j = 0; j < NKEY; ++j) { const size_t krow = j < SEQ ? (size_t)b * SEQ + j : (size_t)M_LAT + b * CTXL + (j - SEQ);
                    float s = 0.f; for (int d = 0; d < 64; ++d) s += bf2f(U1[qrow * U1_LD + 1568 + hd * 128 + mm * 64 + d]) * bf2f(U1[krow * U1_LD + 2080 + hd * 128 + mm * 64 + d]);
                    if (pass == 0) m = fmaxf(m, s); else { const float p = expf(s - m); l += p; oa += p * bf2f(U1[krow * U1_LD + 2592 + hd * 128 + lane]); ob += p * bf2f(U1[krow * U1_LD + 2592 + hd * 128 + 64 + lane]); } }
            if (mm == 0) { o0[0] = oa / l; o0[1] = ob / l; } else { o1[0] = oa / l; o1[1] = ob / l; } }
        const float oa = o0[0] - lam * o1[0], ob = o0[1] - lam * o1[1]; const float rms = 1.f / sqrtf(wsum(oa * oa + ob * ob) / 128.f + RMS_EPS) * (1.f - LAMBDA_INIT);
        const float ra = oa * rms * a.in[I_DNG][lane], rb = ob * rms * a.in[I_DNG][64 + lane]; const float sc = wmax(fmaxf(fabsf(ra), fabsf(rb)));
        const float ga = bf2f(YM[qrow * D + 512 + hd * 128 + lane]), gb = bf2f(YM[qrow * D + 512 + hd * 128 + 64 + lane]);
        if (wany(!chk_close(ga, ra, sc) || !chk_close(gb, rb, sc))) { chk_fail(ctl, 13); return; } }
}
__device__ __forceinline__ void chk_gla(const Args& a, unsigned* ctl, int lane, int b, int h, int dir, LAS float* sh) {
    const bf16* U1 = (const bf16*)(a.ws + WS_R2); const bf16* YM = (const bf16*)(a.ws + WS_H); const bf16* GOB = (const bf16*)(a.ws + WS_GOB);
    float Sa[64], Sb[64]; _Pragma("unroll") for (int k = 0; k < 64; ++k) { Sa[k] = 0.f; Sb[k] = 0.f; }
    float S0[64]; _Pragma("unroll") for (int k = 0; k < 64; ++k) S0[k] = 0.f; float cum = 0.f, mrI = 0.f, msI = 0.f, mrT = 0.f, msT = 0.f;
    bool bad = false; float maxrel = 0.f; int nsmp = 0, firstbad = -1; unsigned bmask = 0u; float minrel = 1e9f;
    for (int st = 0; st < CTXL + SEQ; ++st) { const bool isctx = st < CTXL; const int T = isctx ? CTXL : SEQ; const int tt = isctx ? st : st - CTXL, t = dir ? T - 1 - tt : tt;
        const size_t row = isctx ? (size_t)M_LAT + b * CTXL + t : (size_t)b * SEQ + t; const bf16* ur = U1 + row * U1_LD;
        float s = a.in[I_GLAGB][dir * 256 + h * 64 + lane]; for (int j = 0; j < 16; ++j) s += bf2f(ur[1536 + 16 * dir + j]) * a.in[I_GLAG2][(size_t)(dir * 16 + j) * 256 + h * 64 + lane];
        const float g = (fminf(s, 0.f) - log1pf(expf(-fabsf(s)))) / 16.f;
        sh[lane] = expf(g); sh[64 + lane] = bf2f(ur[256 + h * 64 + lane]); sh[128 + lane] = bf2f(ur[h * 64 + lane]); __syncthreads();
        const float va = bf2f(ur[512 + h * 128 + lane]), vb = bf2f(ur[512 + h * 128 + 64 + lane]); float oa = 0.f, ob = 0.f;
        _Pragma("unroll") for (int k = 0; k < 64; ++k) { Sa[k] = sh[k] * Sa[k] + sh[64 + k] * va; Sb[k] = sh[k] * Sb[k] + sh[64 + k] * vb; oa += sh[128 + k] * Sa[k]; ob += sh[128 + k] * Sb[k]; }
        __syncthreads();
        if (st == CTXL - 1) { _Pragma("unroll") for (int k = 0; k < 64; ++k) S0[k] = Sa[k]; }
        if (st == CTXL - 1 && DBG_MSHIFT == 4) { const float* dq = (const float*)(a.ws + WS_CTL) + 65536 + 4096; float ms = 0.f; int nb = 0;
            _Pragma("unroll") for (int k = 0; k < 64; ++k) ms = fmaxf(ms, fabsf(Sa[k]));
            ms = wmax(ms);
            _Pragma("unroll") for (int k = 0; k < 64; ++k) { if (fabsf(dq[lane * 64 + k] - Sa[k]) > 0.05f * fabsf(Sa[k]) + 1e-3f * ms) ++nb; }
            nb = (int)wsum((float)nb); int c = nb * 60 / 4096; if (nb && !c) c = 1; chk_fail(ctl, 16 + c); return; }
        if (!isctx && st < CTXL + 64 && (DBG_MSHIFT == 2 || DBG_MSHIFT == 3)) { cum += g; sh[320 + lane] = expf(cum); __syncthreads(); float oi = 0.f; _Pragma("unroll") for (int k = 0; k < 64; ++k) oi += sh[128 + k] * sh[320 + k] * S0[k]; __syncthreads();
            const float* dbg = (const float*)(a.ws + WS_CTL) + 32768; const float gi = dbg[(st - CTXL) * 128 + lane], gt = dbg[8192 + (st - CTXL) * 128 + lane];
            if (DBG_MSHIFT == 2 && DBG_QSCHK) { const float* dq = (const float*)(a.ws + WS_CTL) + 65536; const float qref = sh[128 + lane] * sh[320 + lane]; mrI = fmaxf(mrI, fabsf(dq[(st - CTXL) * 64 + lane] - qref)); msI = fmaxf(msI, fabsf(qref)); } else {
            mrI = fmaxf(mrI, fabsf(gi - oi)); msI = fmaxf(msI, fabsf(oi)); } mrT = fmaxf(mrT, fabsf(gt - oa)); msT = fmaxf(msT, fabsf(oa));
            if (st == CTXL + 63) { mrI = wmax(mrI); msI = wmax(msI); mrT = wmax(mrT); msT = wmax(msT); int c = (int)((DBG_MSHIFT == 2 ? mrI / msI : mrT / msT) * 50.f); c = c > 60 ? 60 : c; chk_fail(ctl, 16 + c); return; } }
        if (st == CTXL - 1 && DBG_MSHIFT == 1) { const float* dbg = (const float*)(a.ws + WS_CTL) + 24576; float ms = 0.f; int nb = 0;
            _Pragma("unroll") for (int k = 0; k < 64; ++k) ms = fmaxf(ms, fmaxf(fabsf(Sa[k]), fabsf(Sb[k])));
            ms = wmax(ms);
            _Pragma("unroll") for (int k = 0; k < 64; ++k) { if (fabsf(dbg[lane * 64 + k] - Sa[k]) > 0.05f * fabsf(Sa[k]) + 1e-3f * ms) ++nb; if (fabsf(dbg[(64 + lane) * 64 + k] - Sb[k]) > 0.05f * fabsf(Sb[k]) + 1e-3f * ms) ++nb; }
            nb = (int)wsum((float)nb); int c = nb * 60 / 8192; if (nb && !c) c = 1; chk_fail(ctl, 16 + c); return; }
        if (!isctx && ((st & 255) == 3 || st == CTXL || st == CTXL + 63 || st == CTXL + 64 || st == CTXL + SEQ - 1)) { const bf16* op = dir ? GOB + row * 512 : YM + row * D;
            const float ga = bf2f(op[h * 128 + lane]), gb = bf2f(op[h * 128 + 64 + lane]); const float sc = wmax(fmaxf(fabsf(oa), fabsf(ob)));
            const float rel = wmax(fmaxf(fabsf(ga - oa), fabsf(gb - ob))) / (sc + 1e-6f); maxrel = fmaxf(maxrel, rel); minrel = fminf(minrel, rel); if (rel > 0.05f && firstbad < 0) firstbad = nsmp; if (rel > 0.05f) bmask |= 1u << nsmp; ++nsmp; }
    }
    { int c = (int)((DBG_MSHIFT ? maxrel : minrel) * 50.f); c = c > 60 ? 60 : c; chk_fail(ctl, 16 + c); }
}
__device__ __forceinline__ void chk_act(const Args& a, unsigned* ctl, int lane) {
    const bf16* H = (const bf16*)(a.ws + WS_H); const bf16* ACT = (const bf16*)(a.ws + WS_R2); const float* W = a.in[I_GU0];
    const size_t rows[3] = {0, 20000, (size_t)M_ALL - 1}; bool bad = false;
#pragma unroll
    for (int si = 0; si < 3; ++si) { const size_t row = rows[si]; const int j = (lane * 44 + si * 7) % FF; float g = 0.f, u = 0.f;
        for (int k = 0; k < D; ++k) { const float hv = bf2f(H[row * D + k]); g += hv * W[(size_t)k * NGU + j]; u += hv * W[(size_t)k * NGU + FF + j]; }
        const float ref = g / (1.f + expf(-g)) * u, got = bf2f(ACT[row * FF + j]); if (!chk_close(got, ref, fabsf(ref) + 0.2f)) bad = true; }
    if (wany(bad)) chk_fail(ctl, 3);
}
__device__ __forceinline__ void chk_z(const Args& a, unsigned* ctl, int lane) {
    const bf16* ACT = (const bf16*)(a.ws + WS_R2); const float* W = a.in[I_DN0]; const float* mod = modptr(a, 0);
    const size_t rows[3] = {5, 20000, (size_t)M_ALL - 2}; bool bad = false;
#pragma unroll
    for (int si = 0; si < 3; ++si) { const size_t row = rows[si]; const int col = (lane * 16 + si * 5) % D; float y = 0.f;
        for (int j = 0; j < FF; ++j) y += bf2f(ACT[row * FF + j]) * W[(size_t)j * D + col];
        const bool isctx = row >= (size_t)M_LAT; const int set = isctx ? 16 : (int)(row >> 11); const float x = isctx ? a.in[I_CTX][(row - M_LAT) * D + col] : a.in[I_X][row * D + col];
        const float ref = ALPHA * x + mod[(size_t)(set * 9 + 2) * D + col] * 0.5f * y, got = isctx ? ((const float*)(a.ws + WS_XSC))[(row - M_LAT) * D + col] : a.out[row * D + col];
        if (fabsf(got - ref) > 0.003f + 0.002f * fabsf(ref)) bad = true; }
    if (wany(bad)) chk_fail(ctl, 4);
}
__device__ __forceinline__ void chk_mod(const Args& a, unsigned* ctl, int lane) {
    bool bad = false;
#pragma unroll
    for (int si = 0; si < 4; ++si) { const int l = si & 1, set = si == 3 ? 16 : si * 5, n = (lane * 144 + si * 1000 + 7) % (NMOD * D); float s = a.in[I_BMOD0 + l * LSTRIDE][n];
        for (int k = 0; k < D; ++k) { const float c = set < 16 ? a.in[I_C][set * D + k] : a.in[I_CCTX][k]; s += c / (1.f + expf(-c)) * a.in[I_WMOD0 + l * LSTRIDE][(size_t)k * (NMOD * D) + n]; }
        if (fabsf(modptr(a, l)[(size_t)set * (NMOD * D) + n] - s) > 1e-3f) bad = true; }
    if (wany(bad)) chk_fail(ctl, 1);
}
__device__ __forceinline__ void chk_u0(const Args& a, unsigned* ctl, int lane) {
    const bf16* H = (const bf16*)(a.ws + WS_H); const float* W = a.in[I_WIN0]; const bf16* UA = (const bf16*)(a.ws + WS_R2); const bf16* UB = (const bf16*)(a.ws + WS_R3);
    const size_t rows[3] = {1, 17000, (size_t)M_ALL - 3}; bool bad = false;
#pragma unroll
    for (int si = 0; si < 3; ++si) { const size_t row = rows[si]; const int col = (lane * 54 + si * 11) % NIN0; float u = 0.f;
        for (int k = 0; k < D; ++k) u += bf2f(H[row * D + k]) * W[(size_t)k * NIN0 + col];
        if (col >= 1920 && col < 2432) u *= 0.125f;
        const float got = col < 1920 ? bf2f(UA[row * UA_LD + col]) : bf2f(UB[row * UB_LD + col - 1920]); if (!chk_close(got, u, fabsf(u) + 0.2f)) bad = true; }
    if (wany(bad)) chk_fail(ctl, 6);
}
__device__ __forceinline__ void chk_ln(const Args& a, unsigned* ctl, int lane, int lni, int ish, int isc) {
    const bf16* H = (const bf16*)(a.ws + WS_H); const float* mod = modptr(a, 0); bool bad = false;
    const size_t rows[3] = {3, 30000, (size_t)M_ALL - 5};
#pragma unroll
    for (int si = 0; si < 3; ++si) { const size_t row = rows[si]; const bool isctx = row >= (size_t)M_LAT; const int set = isctx ? 16 : (int)(row >> 11);
        const float* xr = isctx ? (const float*)(a.ws + WS_XSC) + (row - M_LAT) * D : a.out + row * D; float s = 0.f, s2 = 0.f;
        for (int j = 0; j < 16; ++j) { const int c = lane + 64 * j; const float x = xr[c], n = (x - a.in[I_LNB0][lni * D + c]) / a.in[I_LNG0][lni * D + c]; s += n; s2 += n * n;
            const float h = x * (1.f + mod[(size_t)(set * 9 + isc) * D + c]) + mod[(size_t)(set * 9 + ish) * D + c]; if (!chk_close(bf2f(H[row * D + c]), h, fabsf(h))) bad = true; }
        const float mean = wsum(s) / D, var = wsum(s2) / D - mean * mean; if (fabsf(mean) > 1e-3f || fabsf(var - 1.f) > 1e-3f) bad = true; }
    if (wany(bad)) chk_fail(ctl, 5);
}
__global__ void __launch_bounds__(64) chk_kernel(Args a, int id) {
    __shared__ float sh[512]; unsigned* ctl = (unsigned*)(a.ws + WS_CTL); const int lane = threadIdx.x; LAS float* shl = (LAS float*)sh;
    if (id == 1) chk_mod(a, ctl, lane);
    if (id == 3) chk_act(a, ctl, lane);
    if (id == 4) chk_z(a, ctl, lane);
    if (id == 5) chk_ln(a, ctl, lane, 0, 3, 4);
    if (id == 6) chk_u0(a, ctl, lane);
    if (id == 7) chk_na(a, ctl, lane);
    if (id == 8) { if (blockIdx.x == 0) chk_rwkv_scan(a, ctl, lane, 1, 2, 0, shl); else chk_rwkv_scan(a, ctl, lane, 14, 5, 1, shl); }
    if (id == 9) chk_rwkv_post(a, ctl, lane);
    if (id == 13) chk_diff(a, ctl, lane);
    if (id == 14) { if (blockIdx.x == 0) chk_gla(a, ctl, lane, 2, 1, DBG_GLADIR, shl); }
}
__global__ void chk_apply(Args a) { const unsigned code = ((const unsigned*)(a.ws + WS_CTL))[CW_CHK]; if (!code) return;
    for (size_t i = (size_t)blockIdx.x * blockDim.x + threadIdx.x; i < (size_t)M_LAT * D; i += (size_t)gridDim.x * blockDim.x) a.out[i] += 0.1f * (float)code; }
#endif

#ifndef MK_MULTI
#define MK_MULTI 0
#endif
constexpr int PH_PER_LAYER = 13, N_PHASES = 2 + 2 * PH_PER_LAYER;
#define IN(k) (lo <= (k) && (k) < hi)
#define PHMARK(k) asm volatile("; PHMARK " #k ::: "memory")
#define SEAM(k) do { if (IN(k) && IN((k) + 1)) xcd_barrier(bar); else __syncthreads(); } while (0)
template <int l> __device__ __forceinline__ void layer_body(const Args& a, const Blk& B, const XcdBarrier& bar, volatile LAS unsigned* MISC, unsigned* ctl, int lo, int hi) {
    float* xs_lat = a.out; float* xs_ctx = (float*)(a.ws + WS_XSC); bf16* H = (bf16*)(a.ws + WS_H); bf16* ACT = (bf16*)(a.ws + WS_R2);

        const int pb = 2 + PH_PER_LAYER * l, lofs = l * LSTRIDE; const float* modl = modptr(a, l);
        const float* lng = a.in[I_LNG0 + lofs]; const float* lnb = a.in[I_LNB0 + lofs];
        const int m_post = l == 0 ? M_ALL : M_LAT;
        if (IN(pb + 0)) PHMARK(pb + 0); if (IN(pb + 0)) for (int rep = 0; rep < REP_GEMM; ++rep) { __syncthreads(); pg8::Gemm g{H, wptr(a, l, W_GU), M_ALL, NGU, D}; pg8::StaticOrder S; S.init(M_ALL, NGU, B.G, B.bid); pg8::EpiGU E{ACT, FF};
            pg8::gemm_phase<pg8::EpiGU, pg8::StaticOrder, true, true>(B.lds, g, S, E); }
        SEAM(pb + 0);
        if (IN(pb + 1)) PHMARK(pb + 1); if (IN(pb + 1)) { pg8::Gemm g{ACT, wptr(a, l, W_DN), M_ALL, D, FF}; pg8::StaticOrder S; S.init(M_ALL, D, B.G, B.bid);
            pg8::EpiRes E{l == 0 ? a.in[I_X] : xs_lat, l == 0 ? a.in[I_CTX] : xs_ctx, xs_lat, xs_ctx, modl, 2, 0.5f * DBG_S_FFN, ALPHA};
            pg8::gemm_phase<pg8::EpiRes, pg8::StaticOrder, true, true>(B.lds, g, S, E); }
        SEAM(pb + 1);
        if (IN(pb + 2)) PHMARK(pb + 2); if (IN(pb + 2)) ln_phase(B, xs_lat, xs_ctx, M_ALL, lng, lnb, modl, 3, 4, H);
        SEAM(pb + 2);
        if (IN(pb + 3)) PHMARK(pb + 3); if (IN(pb + 3)) for (int rep = 0; rep < REP_GEMM; ++rep) { __syncthreads(); pg8::Gemm g{H, wptr(a, l, W_IN), M_ALL, l == 0 ? NIN0P : NIN1P, D}; pg8::StaticOrder S; S.init(M_ALL, g.N, B.G, B.bid);
            pg8::EpiIn E; E.Oa = (bf16*)(a.ws + WS_R2); E.Ob = (bf16*)(a.ws + WS_R3);
            if (l == 0) { E.lda = UA_LD; E.split = 1920; E.ldb = UB_LD; E.nvalid = NIN0; E.s1lo = 1920; E.s1hi = 2432; E.s2lo = 0; E.s2hi = 0; }
            else { E.lda = U1_LD; E.split = NIN1; E.ldb = 0; E.nvalid = NIN1; E.s1lo = 0; E.s1hi = 256; E.s2lo = 1568; E.s2hi = 2080; }
            pg8::gemm_phase<pg8::EpiIn, pg8::StaticOrder, true, true>(B.lds, g, S, E); }
        SEAM(pb + 3);
        if (l == 0) {
            if (IN(pb + 4)) PHMARK(pb + 4); if (IN(pb + 4)) vt_build<64>(B, (const bf16*)(a.ws + WS_R3), UB_LD, 1024, 8, (bf16*)(a.ws + WS_VT0));
            SEAM(pb + 4);
            if (IN(pb + 5)) PHMARK(pb + 5); if (IN(pb + 5)) for (int rep = 0; rep < REP_NA; ++rep) { __syncthreads(); na_phase(a, B); }
            SEAM(pb + 5);
            if (IN(pb + 6)) PHMARK(pb + 6); if (IN(pb + 6)) for (int rep = 0; rep < REP_SCAN; ++rep) { __syncthreads(); rwkv_scan_phase(a, B); }
            SEAM(pb + 6);
            if (IN(pb + 7)) PHMARK(pb + 7); if (IN(pb + 7)) for (int rep = 0; rep < REP_POST; ++rep) { __syncthreads(); rwkv_post_phase(a, B); }
            SEAM(pb + 7);
        } else {
            if (IN(pb + 4)) PHMARK(pb + 4); if (IN(pb + 4)) { rope_phase(a, B); vt_build<128>(B, (const bf16*)(a.ws + WS_R2), U1_LD, 2592, 4, (bf16*)(a.ws + WS_VT1)); }
            SEAM(pb + 4);
            if (IN(pb + 5)) PHMARK(pb + 5); if (IN(pb + 5)) {
                for (int scan = B.bid; scan < 128; scan += B.G) gla_scan(a, B, scan);
                const float* lp = a.in[I_DLAM]; const float lam = __expf(wave_sum(lp[B.lane] * lp[64 + B.lane])) - __expf(wave_sum(lp[128 + B.lane] * lp[192 + B.lane])) + LAMBDA_INIT;
                for (;;) { __syncthreads(); if (B.tid == 0) MISC[16] = __hip_atomic_fetch_add(ctl + CW_Q, 1u, RLX_AGENT); __syncthreads();
                    const int u = (int)MISC[16]; if (u >= NB * 4 * 8) break;
                    diff_block(a, B, u >> 5, (u >> 3) & 3, u & 7, lam); }
            }
            if (IN(pb + 5) && IN(pb + 7)) xcd_barrier(bar); else __syncthreads();
            if (IN(pb + 7)) PHMARK(pb + 7); if (IN(pb + 7)) gla_post_phase(a, B);
            SEAM(pb + 7);
        }
        if (IN(pb + 8)) PHMARK(pb + 8); if (IN(pb + 8)) { pg8::Gemm g{H, wptr(a, l, W_OUT), m_post, D, D}; pg8::StaticOrder S; S.init(m_post, D, B.G, B.bid);
            pg8::EpiRes E{xs_lat, xs_ctx, xs_lat, xs_ctx, modl, 5, 1.0f, ALPHA};
            pg8::gemm_phase<pg8::EpiRes, pg8::StaticOrder, true, true>(B.lds, g, S, E); }
        SEAM(pb + 8);
        if (IN(pb + 9)) PHMARK(pb + 9); if (IN(pb + 9)) ln_phase(B, xs_lat, xs_ctx, m_post, lng + D, lnb + D, modl, 6, 7, H);
        SEAM(pb + 9);
        if (IN(pb + 10)) PHMARK(pb + 10); if (IN(pb + 10)) for (int rep = 0; rep < REP_GEMM; ++rep) { __syncthreads(); pg8::Gemm g{H, wptr(a, l, W_GU) + (size_t)NGU * D, m_post, NGU, D}; pg8::StaticOrder S; S.init(m_post, NGU, B.G, B.bid); pg8::EpiGU E{ACT, FF};
            pg8::gemm_phase<pg8::EpiGU, pg8::StaticOrder, true, true>(B.lds, g, S, E); }
        SEAM(pb + 10);
        if (IN(pb + 11)) PHMARK(pb + 11); if (IN(pb + 11)) { pg8::Gemm g{ACT, wptr(a, l, W_DN) + (size_t)D * FF, m_post, D, FF}; pg8::StaticOrder S; S.init(m_post, D, B.G, B.bid);
            pg8::EpiRes E{xs_lat, xs_ctx, xs_lat, xs_ctx, modl, 8, 0.5f * DBG_S_FFN, ALPHA};
            pg8::gemm_phase<pg8::EpiRes, pg8::StaticOrder, true, true>(B.lds, g, S, E); }
        SEAM(pb + 11);
        if (IN(pb + 12)) PHMARK(pb + 12); if (IN(pb + 12)) { if (l == 0) ln_phase(B, xs_lat, xs_ctx, M_ALL, lng + 2 * D, lnb + 2 * D, modptr(a, 1), 0, 1, H); else ln_phase(B, xs_lat, xs_ctx, M_LAT, lng + 2 * D, lnb + 2 * D, nullptr, 0, 0, H); }
        if (l == 0) SEAM(pb + 12);
    }
__global__ void __launch_bounds__(NWAVES * 64, 2) fwd_kernel(Args a) {
    extern __shared__ __attribute__((aligned(16))) unsigned char lds_raw[];
    Blk B; B.lds = (LAS unsigned char*)lds_raw; B.tid = threadIdx.x; B.lane = B.tid & 63; B.wave = __builtin_amdgcn_readfirstlane(B.tid >> 6); B.G = gridDim.x; B.bid = blockIdx.x;
    volatile LAS unsigned* MISC = (volatile LAS unsigned*)(B.lds + MISC_OFF);
    if (B.tid < 64) MISC[B.tid] = 0u;
    __syncthreads();
    unsigned* ctl = (unsigned*)(a.ws + WS_CTL);
    const int lo = a.ph_lo, hi = a.ph_hi;
    XcdBarrier bar; bar.bar = ctl + CW_BAR; bar.x = 0; bar.st = MISC + 8;
    if (hi - lo > 1) bar = xcd_barrier_post(ctl + CW_BAR, MISC + 8);

    if (IN(0)) PHMARK(0); if (IN(0)) { p0_prologue(a, B); } SEAM(0);
    if (IN(1)) PHMARK(1); if (IN(1)) { p1_h0(a, B); } SEAM(1);

    layer_body<0>(a, B, bar, MISC, ctl, lo, hi);
    layer_body<1>(a, B, bar, MISC, ctl, lo, hi);
#undef IN
#undef SEAM
}

extern "C" void kernel_launch(void* const* d_in, const int* in_sizes, int n_in, void* d_out, int out_size, void* d_ws, size_t ws_size, hipStream_t stream) {
    static int grid = 0;
    if (grid == 0) {
        if (n_in != N_IN || out_size != M_LAT * D || ws_size < WS_END) { fprintf(stderr, "kernel_launch: unexpected problem shape (n_in %d, out %d, ws %zu)\n", n_in, out_size, ws_size); grid = -1; return; }
        int dev = 0, cus = 0, per_cu = 0;
        if (hipGetDevice(&dev) != hipSuccess || hipDeviceGetAttribute(&cus, hipDeviceAttributeMultiprocessorCount, dev) != hipSuccess) { grid = -1; return; }
        if (hipFuncSetAttribute((const void*)fwd_kernel, hipFuncAttributeMaxDynamicSharedMemorySize, LDS_BYTES) != hipSuccess) { fprintf(stderr, "kernel_launch: hipFuncSetAttribute failed\n"); grid = -1; return; }
        if (hipOccupancyMaxActiveBlocksPerMultiprocessor(&per_cu, (const void*)fwd_kernel, NWAVES * 64, LDS_BYTES) != hipSuccess || per_cu < 1) fprintf(stderr, "kernel_launch: occupancy query reports %d\n", per_cu);
        (void)hipGetLastError();
        grid = cus;
    }
    if (grid < 0) return;
    if (hipMemsetAsync((char*)d_ws + WS_CTL, 0, CTL_BYTES, stream) != hipSuccess) return;
    Args a{};
    for (int i = 0; i < N_IN; ++i) a.in[i] = (const float*)d_in[i];
    a.out = (float*)d_out; a.ws = (unsigned char*)d_ws;
#if MK_MULTI
    for (int p = 0; p < N_PHASES; ++p) { if (p == 2 + PH_PER_LAYER + 6) continue; a.ph_lo = p; a.ph_hi = p + 1; hipLaunchKernelGGL(fwd_kernel, dim3(grid), dim3(NWAVES * 64), LDS_BYTES, stream, a);
#if DBG_CHECKS
        { Args c = a; c.ph_lo = 0; c.ph_hi = 0; int ids[2] = {0, 0};
          if (p == 0) ids[0] = 1; if (p == 2) ids[0] = 3; if (p == 3) ids[0] = 4; if (p == 4) ids[0] = 5; if (p == 5) ids[0] = 6; if (p == 7) ids[0] = 7; if (p == 8) ids[0] = 8; if (p == 9) ids[0] = 9;
          if (p == 20) { ids[0] = 13; ids[1] = 14; }
          for (int q = 0; q < 2; ++q) if (ids[q] && (DBG_CHECKS & (1 << ids[q]))) hipLaunchKernelGGL(chk_kernel, dim3((ids[q] == 8 || ids[q] == 14) ? 2 : 1), dim3(64), 0, stream, c, ids[q]); }
#endif
    }
#if DBG_CHECKS
    { Args c = a; c.ph_lo = 0; c.ph_hi = 0; hipLaunchKernelGGL(chk_apply, dim3(1024), dim3(256), 0, stream, c); }
#endif
#else
    a.ph_lo = 0; a.ph_hi = N_PHASES; hipLaunchKernelGGL(fwd_kernel, dim3(grid), dim3(NWAVES * 64), LDS_BYTES, stream, a);
#endif
}
```

```cpp
#include <hip/hip_runtime.h>
#include <cstdio>
#include <cstdint>
namespace pg8 {
#define PG8_LAS __attribute__((address_space(3)))
typedef unsigned short bf16_t;
typedef short bf16x8 __attribute__((ext_vector_type(8)));
typedef float f32x4 __attribute__((ext_vector_type(4)));
typedef unsigned u32x4 __attribute__((ext_vector_type(4)));
constexpr int BM = 256, BK = 64, HALF = 128, HTB = HALF * BK * 2  , STAGE_BYTES = 8 * HTB, NXCD = 8, WGM = 8;

__host__ __device__ __forceinline__ int lds_byte(int r, int c) { const int st = (r >> 4) * 2 + (c >> 5), rr = r & 15, cc = c & 31, ob = rr * 64 + cc * 2; return st * 1024 + (ob ^ (((ob >> 9) & 1) << 5)); }
__host__ __device__ __forceinline__ void stage_rc(int b, int& R, int& C) { const int st = b / 1024, sb = b % 1024, swz = sb ^ (((sb >> 9) & 1) << 5); R = (st >> 1) * 16 + swz / 64; C = (st & 1) * 32 + (swz % 64) / 2; }
__host__ __device__ __forceinline__ int perm32(int rho) { const int n = rho >> 4, i = rho & 15; return 8 * (i >> 2) + 4 * n + (i & 3); }

struct Unit { int pm, pn; };
struct Gemm { const bf16_t* A; const bf16_t* Bt; int M, N, K; };

struct StaticOrder {
    int nM, nN, nwg, G, c;
    __host__ __device__ void init(int M, int N, int G_, int c_) { nM = M / BM; nN = N / BM; nwg = nM * nN; G = G_; c = c_; }
    __host__ __device__ bool next(int i, Unit& u) const {
        const long L = (long)i * G + c; if (L >= nwg) return false;
        int wgid = (int)L; { const int q = nwg / NXCD, r = nwg % NXCD, xcd = wgid % NXCD, off = wgid / NXCD; wgid = (xcd < r ? xcd * (q + 1) : r * (q + 1) + (xcd - r) * q) + off; }
        const int nig = WGM * nN, gid = wgid / nig, fm = gid * WGM, gsz = (nM - fm) < WGM ? (nM - fm) : WGM;
        u.pm = fm + ((wgid % nig) % gsz); u.pn = (wgid % nig) / gsz; return true;
    }
    __device__ __forceinline__ void a_ready(const Unit&) const {}
    __device__ __forceinline__ void done(const Unit&) const {}
};

__device__ __forceinline__ unsigned cvt_pk_bf16(float lo, float hi) { unsigned r; asm volatile("v_cvt_pk_bf16_f32 %0, %1, %2" : "=v"(r) : "v"(lo), "v"(hi)); return r; }
typedef unsigned u32x2 __attribute__((ext_vector_type(2)));
__device__ __forceinline__ float silu_f(float x) { return x * __builtin_amdgcn_rcpf(1.0f + __expf(-x)); }

struct EpiGU {
    static constexpr bool PERM = true, AFTER_DRAIN = false;
    bf16_t* O; int ldo;
    __device__ __forceinline__ void operator()(const f32x4 (&acc)[2][2][4][2], const Unit& u, int wr, int wc, int fr, int fq) const {
        const int row0 = u.pm * BM + wr * 64 + fr, j0 = u.pn * 128 + wc * 16 + 4 * fq;
#pragma unroll
        for (int ai = 0; ai < 2; ++ai)
#pragma unroll
            for (int m = 0; m < 4; ++m) { bf16_t* rowp = O + (size_t)(row0 + ai * HALF + m * 16) * ldo + j0;
#pragma unroll
                for (int bj = 0; bj < 2; ++bj) { const f32x4 g = acc[ai][bj][m][0], up = acc[ai][bj][m][1];
                    u32x2 w; w.x = cvt_pk_bf16(silu_f(g[0]) * up[0], silu_f(g[1]) * up[1]); w.y = cvt_pk_bf16(silu_f(g[2]) * up[2], silu_f(g[3]) * up[3]);
                    *(u32x2*)(rowp + bj * 64) = w; } }
    }
};
struct EpiRes {
    static constexpr bool PERM = false, AFTER_DRAIN = false;
    const float* resid_lat; const float* resid_ctx; float* out_lat; float* out_ctx; const float* modl; int gidx; float gs, alpha;
    __device__ __forceinline__ void operator()(const f32x4 (&acc)[2][2][4][2], const Unit& u, int wr, int wc, int fr, int fq) const {
        const int col0 = u.pn * BM + wc * 32 + 4 * fq; const bool isctx = u.pm >= 128; const int set = isctx ? 16 : (u.pm >> 3);
        const int rloc = (isctx ? (u.pm - 128) : u.pm) * BM + wr * 64 + fr;
        const float* rb = isctx ? resid_ctx : resid_lat; float* ob = isctx ? out_ctx : out_lat; const float* gp = modl + (size_t)(set * 9 + gidx) * 1024 + col0;
        f32x4 gv[2][2];
#pragma unroll
        for (int bj = 0; bj < 2; ++bj)
#pragma unroll
            for (int n = 0; n < 2; ++n) gv[bj][n] = *(const f32x4*)(gp + bj * HALF + n * 16) * gs;
#pragma unroll
        for (int ai = 0; ai < 2; ++ai)
#pragma unroll
            for (int m = 0; m < 4; ++m) { const size_t off = (size_t)(rloc + ai * HALF + m * 16) * 1024 + col0;
#pragma unroll
                for (int bj = 0; bj < 2; ++bj)
#pragma unroll
                    for (int n = 0; n < 2; ++n) { const f32x4 x = *(const f32x4*)(rb + off + bj * HALF + n * 16);
                        *(f32x4*)(ob + off + bj * HALF + n * 16) = x * alpha + gv[bj][n] * acc[ai][bj][m][n]; } }
    }
};
struct EpiIn {
    static constexpr bool PERM = true, AFTER_DRAIN = false;
    bf16_t* Oa; int lda; int split; bf16_t* Ob; int ldb; int nvalid; int s1lo, s1hi, s2lo, s2hi;
    __device__ __forceinline__ void operator()(const f32x4 (&acc)[2][2][4][2], const Unit& u, int wr, int wc, int fr, int fq) const {
        const int row0 = u.pm * BM + wr * 64 + fr;
#pragma unroll
        for (int bj = 0; bj < 2; ++bj) { const int c0 = u.pn * BM + bj * HALF + wc * 32 + 8 * fq;
            if (c0 < nvalid) { const float sc = ((c0 >= s1lo && c0 < s1hi) || (c0 >= s2lo && c0 < s2hi)) ? 0.125f : 1.0f;
                bf16_t* base = (c0 < split) ? (Oa + c0) : (Ob + (c0 - split)); const int ld = (c0 < split) ? lda : ldb;
#pragma unroll
                for (int ai = 0; ai < 2; ++ai)
#pragma unroll
                    for (int m = 0; m < 4; ++m) { const f32x4 v0 = acc[ai][bj][m][0] * sc, v1 = acc[ai][bj][m][1] * sc;
                        u32x4 w; w.x = cvt_pk_bf16(v0[0], v0[1]); w.y = cvt_pk_bf16(v0[2], v0[3]); w.z = cvt_pk_bf16(v1[0], v1[1]); w.w = cvt_pk_bf16(v1[2], v1[3]);
                        *(u32x4*)(base + (size_t)(row0 + ai * HALF + m * 16) * ld) = w; } } }
    }
};
template <class Epi, class Sched, bool ALIGN_EPI = false, bool SP2 = false>
__device__ __forceinline__ void gemm_phase(PG8_LAS unsigned char* lds, const Gemm g, const Sched& S, const Epi& E) {
    const int tid = threadIdx.x, wid = __builtin_amdgcn_readfirstlane(tid >> 6), lane = tid & 63, wr = wid >> 2, wc = wid & 3, fr = lane & 15, fq = lane >> 4;
    const int K = g.K, nt = K / BK;
    unsigned voffA[2], voffB[2];
#pragma unroll
    for (int i = 0; i < 2; ++i) { int R, C; stage_rc(tid * 16 + i * 8192, R, C); const int Rb = Epi::PERM ? ((R & ~31) + perm32(R & 31)) : R;
        voffA[i] = (unsigned)(R * K + C) * 2u; voffB[i] = (unsigned)(Rb * K + C) * 2u; }
    const size_t kstep = (size_t)(BK * 2);
    const size_t hstep = (size_t)HALF * K * 2;
    const size_t tstep = 2 * hstep;
    const unsigned ldsw = (unsigned)wid * 1024u;
    const int aoff = lds_byte(wr * 64 + fr, fq * 8), boff = lds_byte(wc * 32 + fr, fq * 8);
#define PG8_SA(b, h) (((b) * 2 + (h)) * HTB)
#define PG8_SB(b, h) ((4 + (b) * 2 + (h)) * HTB)
#define PG8_STAGE(bufoff, gbase, voff) do { _Pragma("unroll") for (int _i = 0; _i < 2; ++_i) \
        __builtin_amdgcn_global_load_lds((const unsigned*)((const char*)(gbase) + (voff)[_i]), (PG8_LAS unsigned*)(lds + (bufoff) + ldsw + _i * 8192), 16, 0, 0); } while (0)
#define PG8_LDA(dst, b, h) do { _Pragma("unroll") for (int m = 0; m < 4; ++m) _Pragma("unroll") for (int k = 0; k < 2; ++k) dst[m][k] = *(const PG8_LAS bf16x8*)(lds + PG8_SA(b, h) + aoff + m * 2048 + k * 1024); } while (0)
#define PG8_LDB(dst, b, h) do { _Pragma("unroll") for (int n = 0; n < 2; ++n) _Pragma("unroll") for (int k = 0; k < 2; ++k) dst[n][k] = *(const PG8_LAS bf16x8*)(lds + PG8_SB(b, h) + boff + n * 2048 + k * 1024); } while (0)
#define PG8_MMA(ai, bj, At, Bt) do { __builtin_amdgcn_s_setprio(1); _Pragma("unroll") for (int m = 0; m < 4; ++m) _Pragma("unroll") for (int n = 0; n < 2; ++n) _Pragma("unroll") for (int k = 0; k < 2; ++k) \
        acc[ai][bj][m][n] = __builtin_amdgcn_mfma_f32_16x16x32_bf16(Bt[n][k], At[m][k], acc[ai][bj][m][n], 0, 0, 0); __builtin_amdgcn_s_setprio(0); } while (0)
#define PG8_WAIT_V(n) asm volatile("s_waitcnt vmcnt(" #n ")" ::: "memory")
#define PG8_WAIT_L(n) asm volatile("s_waitcnt lgkmcnt(" #n ")" ::: "memory")
#define PG8_BAR __builtin_amdgcn_s_barrier()
#define PG8_SCHED __builtin_amdgcn_sched_barrier(0)
    Unit cur, nxt; int ui = 0;
    if (!S.next(0, cur)) return;
    f32x4 acc[2][2][4][2];
#pragma unroll
    for (int a = 0; a < 2; ++a)
#pragma unroll
        for (int b = 0; b < 2; ++b)
#pragma unroll
            for (int m = 0; m < 4; ++m)
#pragma unroll
                for (int n = 0; n < 2; ++n) acc[a][b][m][n] = (f32x4){0.f, 0.f, 0.f, 0.f};
    bf16x8 At[4][2], B0[2][2], B1[2][2];
    const char* cA = (const char*)g.A + (size_t)cur.pm * tstep; const char* cB = (const char*)g.Bt + (size_t)cur.pn * tstep;
    S.a_ready(cur);
    if constexpr (SP2) {
        PG8_STAGE(PG8_SB(0, 0), cB, voffB); PG8_STAGE(PG8_SB(0, 1), cB + hstep, voffB); PG8_STAGE(PG8_SA(0, 0), cA, voffA); PG8_STAGE(PG8_SA(0, 1), cA + hstep, voffA);
        if (wr == 1) PG8_BAR;
        PG8_WAIT_V(2); PG8_BAR;
        PG8_STAGE(PG8_SB(1, 0), cB + kstep, voffB); PG8_STAGE(PG8_SA(1, 0), cA + kstep, voffA); PG8_STAGE(PG8_SB(1, 1), cB + hstep + kstep, voffB);
        PG8_WAIT_V(6); PG8_BAR;
    } else {
        PG8_STAGE(PG8_SB(0, 0), cB, voffB); PG8_STAGE(PG8_SA(0, 0), cA, voffA); PG8_STAGE(PG8_SB(0, 1), cB + hstep, voffB); PG8_STAGE(PG8_SA(0, 1), cA + hstep, voffA);
        if (wr == 1) PG8_BAR;
        PG8_WAIT_V(4); PG8_BAR;
        PG8_STAGE(PG8_SB(1, 0), cB + kstep, voffB); PG8_STAGE(PG8_SA(1, 0), cA + kstep, voffA); PG8_STAGE(PG8_SB(1, 1), cB + hstep + kstep, voffB);
        PG8_WAIT_V(6); PG8_BAR;
    }
    for (;;) {
        const bool has_next = S.next(ui + 1, nxt);
        const char* nA = has_next ? (const char*)g.A + (size_t)nxt.pm * tstep : cA; const char* nB = has_next ? (const char*)g.Bt + (size_t)nxt.pn * tstep : cB;
        for (int t = 0; t < nt; t += 2) {
            const bool last = (t == nt - 2);
            const char* a1 = cA + (size_t)(t + 1) * kstep;
            const char* a2 = last ? nA : cA + (size_t)(t + 2) * kstep; const char* b2 = last ? nB : cB + (size_t)(t + 2) * kstep;
            const char* a3 = a2 + kstep; const char* b3 = b2 + kstep;
            if (last && has_next) S.a_ready(nxt);
            if constexpr (SP2) {
            PG8_LDB(B0, 0, 0); PG8_LDB(B1, 0, 1); PG8_SCHED; PG8_LDA(At, 0, 0); PG8_STAGE(PG8_SA(1, 1), a1 + hstep, voffA);
            PG8_WAIT_V(8); PG8_WAIT_L(0); PG8_BAR; PG8_MMA(0, 0, At, B0); PG8_MMA(0, 1, At, B1); PG8_BAR; PG8_SCHED;
            PG8_LDA(At, 0, 1); PG8_STAGE(PG8_SB(0, 0), b2, voffB); PG8_STAGE(PG8_SB(0, 1), b2 + hstep, voffB); PG8_STAGE(PG8_SA(0, 0), a2, voffA);
            PG8_WAIT_V(8); PG8_WAIT_L(0); PG8_BAR; PG8_MMA(1, 0, At, B0); PG8_MMA(1, 1, At, B1); PG8_BAR; PG8_SCHED;
            PG8_LDB(B0, 1, 0); PG8_LDB(B1, 1, 1); PG8_SCHED; PG8_LDA(At, 1, 0); PG8_STAGE(PG8_SA(0, 1), a2 + hstep, voffA);
            PG8_WAIT_V(8); PG8_WAIT_L(0); PG8_BAR; PG8_MMA(0, 0, At, B0); PG8_MMA(0, 1, At, B1); PG8_BAR; PG8_SCHED;
            PG8_LDA(At, 1, 1); PG8_STAGE(PG8_SB(1, 0), b3, voffB); PG8_STAGE(PG8_SB(1, 1), b3 + hstep, voffB); PG8_STAGE(PG8_SA(1, 0), a3, voffA);
            PG8_WAIT_V(8); PG8_WAIT_L(0); PG8_BAR; PG8_MMA(1, 0, At, B0); PG8_MMA(1, 1, At, B1); PG8_BAR; PG8_SCHED;
            } else {
            PG8_LDB(B0, 0, 0); PG8_SCHED; PG8_LDA(At, 0, 0); PG8_STAGE(PG8_SA(1, 1), a1 + hstep, voffA);
            PG8_WAIT_L(8); PG8_BAR; PG8_WAIT_L(0); PG8_MMA(0, 0, At, B0); PG8_BAR; PG8_SCHED;
            PG8_LDB(B1, 0, 1); PG8_STAGE(PG8_SB(0, 0), b2, voffB);
            PG8_BAR; PG8_WAIT_L(0); PG8_MMA(0, 1, At, B1); PG8_BAR;
            PG8_LDA(At, 0, 1); PG8_STAGE(PG8_SA(0, 0), a2, voffA);
            PG8_BAR; PG8_WAIT_L(0); PG8_MMA(1, 0, At, B0); PG8_BAR; PG8_SCHED;
            PG8_STAGE(PG8_SB(0, 1), b2 + hstep, voffB);
            PG8_WAIT_V(6); PG8_BAR; PG8_MMA(1, 1, At, B1); PG8_BAR;
            PG8_LDB(B0, 1, 0); PG8_SCHED; PG8_LDA(At, 1, 0); PG8_STAGE(PG8_SA(0, 1), a2 + hstep, voffA);
            PG8_WAIT_L(8); PG8_BAR; PG8_WAIT_L(0); PG8_MMA(0, 0, At, B0); PG8_BAR; PG8_SCHED;
            PG8_LDB(B1, 1, 1); PG8_STAGE(PG8_SB(1, 0), b3, voffB);
            PG8_BAR; PG8_WAIT_L(0); PG8_MMA(0, 1, At, B1); PG8_BAR;
            PG8_LDA(At, 1, 1); PG8_STAGE(PG8_SA(1, 0), a3, voffA);
            PG8_BAR; PG8_WAIT_L(0); PG8_MMA(1, 0, At, B0); PG8_BAR; PG8_SCHED;
            PG8_STAGE(PG8_SB(1, 1), b3 + hstep, voffB);
            PG8_WAIT_V(6); PG8_BAR; PG8_MMA(1, 1, At, B1); PG8_BAR;
            }
        }
        if constexpr (ALIGN_EPI) { if (wr == 0) PG8_BAR; }
        if constexpr (!Epi::AFTER_DRAIN) { E(acc, cur, wr, wc, fr, fq); S.done(cur); }
        if (!has_next) break;
#pragma unroll
        for (int a = 0; a < 2; ++a)
#pragma unroll
            for (int b = 0; b < 2; ++b)
#pragma unroll
                for (int m = 0; m < 4; ++m)
#pragma unroll
                    for (int n = 0; n < 2; ++n) acc[a][b][m][n] = (f32x4){0.f, 0.f, 0.f, 0.f};
        cur = nxt; cA = nA; cB = nB; ++ui;
        if constexpr (ALIGN_EPI) { if (wr == 1) PG8_BAR; }
    }
    PG8_WAIT_V(0);
    if constexpr (!ALIGN_EPI) { if (wr == 0) PG8_BAR; }
    PG8_BAR;
    if constexpr (Epi::AFTER_DRAIN) { E.fused(acc, cur, wr, wc, fr, fq, lds, wid, lane); S.done(cur); }
#undef PG8_SA
#undef PG8_SB
#undef PG8_STAGE
#undef PG8_LDA
#undef PG8_LDB
#undef PG8_MMA
#undef PG8_WAIT_V
#undef PG8_WAIT_L
#undef PG8_BAR
#undef PG8_SCHED
}
}

#ifndef DBG_Z_RWKV
#define DBG_Z_RWKV 0
#endif
#ifndef DBG_Z_NA
#define DBG_Z_NA 0
#endif
#ifndef DBG_Z_GLA
#define DBG_Z_GLA 0
#endif
#ifndef DBG_Z_DIFF
#define DBG_Z_DIFF 0
#endif
#ifndef DBG_NOYF
#define DBG_NOYF 0
#endif
#ifndef DBG_NOYB
#define DBG_NOYB 0
#endif
#ifndef DBG_NOBONUS
#define DBG_NOBONUS 0
#endif
#ifndef DBG_GLA_NOF
#define DBG_GLA_NOF 0
#endif
#ifndef DBG_GLA_NOB
#define DBG_GLA_NOB 0
#endif
#ifndef DBG_DIFF_LAM0
#define DBG_DIFF_LAM0 0
#endif
#ifndef DBG_NA_NOBIAS
#define DBG_NA_NOBIAS 0
#endif
#ifndef DBG_NA_NOLOCAL
#define DBG_NA_NOLOCAL 0
#endif
#ifndef DBG_NA_NOCTX
#define DBG_NA_NOCTX 0
#endif
#ifndef DBG_S_RWKV
#define DBG_S_RWKV 1.0f
#endif
#ifndef DBG_S_NA
#define DBG_S_NA 1.0f
#endif
#ifndef DBG_S_GLA
#define DBG_S_GLA 1.0f
#endif
#ifndef DBG_S_DIFF
#define DBG_S_DIFF 1.0f
#endif
#ifndef DBG_S_FFN
#define DBG_S_FFN 1.0f
#endif
#ifndef DBG_HZ_RWKV
#define DBG_HZ_RWKV(h) 0
#endif
#ifndef DBG_HZ_NA
#define DBG_HZ_NA(h) 0
#endif
#ifndef DBG_HZ_GLA
#define DBG_HZ_GLA(h) 0
#endif
#ifndef DBG_HZ_DIFF
#define DBG_HZ_DIFF(h) 0
#endif
#ifndef DBG_NOLW
#define DBG_NOLW 0
#endif
#ifndef DBG_NOLA
#define DBG_NOLA 0
#endif
#ifndef DBG_GLA_NOGD
#define DBG_GLA_NOGD 0
#endif
#ifndef DBG_MUS
#define DBG_MUS 1.0f
#endif
#ifndef DBG_ROPE
#define DBG_ROPE 0
#endif
#ifndef DBG_CHECKS
#define DBG_CHECKS 0
#endif
#ifndef REP_GEMM
#define REP_GEMM 1
#endif
#ifndef REP_NA
#define REP_NA 1
#endif
#ifndef REP_SCAN
#define REP_SCAN 1
#endif
#ifndef REP_POST
#define REP_POST 1
#endif
#ifndef REP_H0
#define REP_H0 1
#endif
#ifndef REP_VT
#define REP_VT 1
#endif
#ifndef REP_P5
#define REP_P5 1
#endif
#ifndef DBG_TIMING
#define DBG_TIMING 0
#endif
#ifndef DBG_TCLASS
#define DBG_TCLASS 2
#endif
#ifndef DBG_TUNIT
#define DBG_TUNIT 1000
#endif
#ifndef REP_DN
#define REP_DN 1
#endif
#ifndef REP_P0
#define REP_P0 1
#endif
#ifndef REP_LN
#define REP_LN 1
#endif
constexpr int NWAVES = 8;
constexpr int NB = 16, SEQ = 2048, CTXL = 256, D = 1024, FF = 2816, NGU = 5632, NMOD = 9, GRIDW = 64;
constexpr int M_LAT = NB * SEQ, M_CTX = NB * CTXL, M_ALL = M_LAT + M_CTX;
constexpr int NIN0 = 3456, NIN0P = 3584, NIN1 = 3104, NIN1P = 3328;
constexpr int UA_LD = 1920, UB_LD = 1536, U1_LD = 3104, NKEY = SEQ + CTXL;
constexpr float ALPHA = 1.41421356237f;
constexpr float LN_EPS = 1e-5f, RMS_EPS = 1e-6f, GN_EPS = 64e-5f;
constexpr float LAMBDA_INIT = 0.35550907f;

enum { I_X = 0, I_C, I_CTX, I_CCTX,
       I_WMOD0, I_BMOD0, I_LNG0, I_LNB0, I_GU0, I_DN0, I_WIN0, I_WOUT0, I_MU, I_W0, I_W2, I_A0, I_A2, I_G2, I_KK, I_KA, I_RK, I_GNG, I_GNB, I_RPB,
       I_WMOD1, I_BMOD1, I_LNG1, I_LNB1, I_GU1, I_DN1, I_WIN1, I_WOUT1, I_GLAG2, I_GLAGB, I_GLANG, I_DLAM, I_DNG, N_IN };
constexpr int LSTRIDE = I_WMOD1 - I_WMOD0;

constexpr size_t MiB = 1u << 20;
constexpr size_t WS_CTL = 0, CTL_BYTES = 1 * MiB;
constexpr size_t WS_MOD = 1 * MiB;
constexpr size_t WS_LORA = 4 * MiB;
constexpr size_t WS_W = 5 * MiB, W_LAYER = 42 * MiB;
constexpr size_t W_GU = 0, W_DN = 22 * MiB, W_IN = 33 * MiB, W_OUT = 40 * MiB;
constexpr size_t WS_XSC = 89 * MiB;
constexpr size_t WS_H = 105 * MiB;
constexpr size_t WS_R2 = 177 * MiB;
constexpr size_t WS_R3 = 375 * MiB;
constexpr size_t WS_VT0 = WS_R2 + 135 * MiB;
constexpr size_t WS_Y = WS_R2 + 135 * MiB;
constexpr size_t WS_VT1 = WS_R2 + 219 * MiB;
constexpr size_t WS_GOB = WS_R2 + 255 * MiB;
constexpr size_t WS_END = 489 * MiB;
static_assert(WS_Y + (size_t)2 * M_ALL * 512 * 4 <= WS_END, "Y");
static_assert(WS_GOB + (size_t)M_LAT * 512 * 2 <= WS_END && WS_VT0 + (size_t)NB * 8 * 64 * NKEY * 2 <= WS_R3 && (size_t)M_ALL * U1_LD * 2 <= 219 * MiB, "ws map");
constexpr int CW_BAR = 4096;
constexpr int CW_Q = 16384;

constexpr int LDS_BYTES = 163840 - 512;
constexpr int MISC_OFF = LDS_BYTES - 256;

#define GAS __attribute__((address_space(1)))
#define LAS __attribute__((address_space(3)))
typedef unsigned short bf16;
typedef unsigned v4u __attribute__((ext_vector_type(4)));
typedef unsigned v2u __attribute__((ext_vector_type(2)));
typedef float f32x4 __attribute__((ext_vector_type(4)));
typedef float f32x2 __attribute__((ext_vector_type(2)));
typedef float f32x16 __attribute__((ext_vector_type(16)));
typedef short bf16x8 __attribute__((ext_vector_type(8)));
typedef short s16x4 __attribute__((ext_vector_type(4)));
#define RLX_AGENT __ATOMIC_RELAXED, __HIP_MEMORY_SCOPE_AGENT
#define LDS_WAIT() asm volatile("s_waitcnt lgkmcnt(0)" ::: "memory")
#define VM_WAIT() asm volatile("s_waitcnt vmcnt(0)" ::: "memory")
#define MFMA32(a, b, c) __builtin_amdgcn_mfma_f32_32x32x16_bf16((a), (b), (c), 0, 0, 0)
__device__ __forceinline__ float bf2f(bf16 v) { return __uint_as_float(((unsigned)v) << 16); }
__device__ __forceinline__ float bflo(unsigned w) { return __uint_as_float(w << 16); }
__device__ __forceinline__ float bfhi(unsigned w) { return __uint_as_float(w & 0xffff0000u); }
typedef __bf16 bf16x2_t __attribute__((ext_vector_type(2)));
__device__ __forceinline__ unsigned pk2s(float lo, float hi) { const f32x2 v = {lo, hi}; const bf16x2_t b = __builtin_convertvector(v, bf16x2_t); return __builtin_bit_cast(unsigned, b); }
__device__ __forceinline__ bf16 f2bfs(float f) { return (bf16)(pk2s(f, 0.f) & 0xffffu); }
__device__ __forceinline__ unsigned pk2(float lo, float hi) { return pg8::cvt_pk_bf16(lo, hi); }
__device__ __forceinline__ bf16 f2bf(float f) { return (bf16)(pk2(f, 0.f) & 0xffffu); }
__device__ __forceinline__ float sigmoid_f(float x) { return 1.0f / (1.0f + __expf(-x)); }
__device__ __forceinline__ float xhalf_max(float v) { auto rr = __builtin_amdgcn_permlane32_swap(__float_as_uint(v), __float_as_uint(v), false, false); return fmaxf(__uint_as_float(rr[0]), __uint_as_float(rr[1])); }
__device__ __forceinline__ float xhalf_sum(float v) { auto rr = __builtin_amdgcn_permlane32_swap(__float_as_uint(v), __float_as_uint(v), false, false); return __uint_as_float(rr[0]) + __uint_as_float(rr[1]); }
template <int CTRL> __device__ __forceinline__ float dpp_f(float v) { return __uint_as_float((unsigned)__builtin_amdgcn_update_dpp(0, (int)__float_as_uint(v), CTRL, 0xf, 0xf, true)); }
__device__ __forceinline__ float row16_sum(float v) {
    v += dpp_f<0xB1>(v); v += dpp_f<0x4E>(v); v += dpp_f<0x141>(v); v += dpp_f<0x140>(v); return v;
}

__device__ __forceinline__ float wave_sum(float v) { v = row16_sum(v); v += __shfl_xor(v, 16); return xhalf_sum(v); }

struct Args { const float* in[N_IN]; float* out; unsigned char* ws; int ph_lo, ph_hi; };
struct Blk { LAS unsigned char* lds; int tid, lane, wave, G, bid; };
#define XB_TMO      128
#define XB_XCNT(j)  (256  + 64 * (j))
#define XB_XSUB(j)  (1280 + 64 * (j))
#define XB_XGEN(j)  (2304 + 64 * (j))
#define XB_TOP      3328
#define XB_TOPGEN   3392
#define XCD_BAR_WORDS 3456
#define XB_SPIN_CAP (1u << 18)

__device__ __forceinline__ unsigned xb_ld(unsigned* p)              { return __hip_atomic_load(p, __ATOMIC_RELAXED, __HIP_MEMORY_SCOPE_AGENT); }
__device__ __forceinline__ unsigned xb_add(unsigned* p, unsigned v) { return __hip_atomic_fetch_add(p, v, __ATOMIC_RELAXED, __HIP_MEMORY_SCOPE_AGENT); }
__device__ __forceinline__ unsigned xb_xcc_id() { return (unsigned)__builtin_amdgcn_s_getreg((3 << 11) | 20) & 0xFu; }
#define XB_SPIN(cond, bar) do { unsigned _sp = 0; while (cond) { __builtin_amdgcn_s_sleep(1); \
    if ((++_sp & 255u) == 0u) { if (xb_ld(&(bar)[XB_TMO])) break; if (_sp > XB_SPIN_CAP) { atomicAdd(&(bar)[XB_TMO], 1u); break; } } } } while (0)

struct XcdBarrier {
    unsigned* bar; unsigned x;
    volatile LAS unsigned* st;
};

__device__ __forceinline__ XcdBarrier xcd_barrier_post(unsigned* bar, volatile LAS unsigned* st) {
    XcdBarrier b; b.bar = bar; b.x = xb_xcc_id(); b.st = st;
    if (threadIdx.x == 0) (void)xb_add(&bar[XB_XCNT(b.x)], 1u);
    return b;
}
__device__ __forceinline__ void xcd_barrier_complete(unsigned* bar, unsigned x, unsigned& nloc, unsigned& nx) {
    const unsigned G = gridDim.x * gridDim.y * gridDim.z;
    unsigned sum, cnt, mine, sp = 0u;
    for (;;) {
        sum = 0u; cnt = 0u; mine = 0u;
#pragma unroll
        for (unsigned j = 0; j < 16; ++j) { const unsigned c = xb_ld(&bar[XB_XCNT(j)]); sum += c; cnt += (c > 0u) ? 1u : 0u; mine = (j == x) ? c : mine; }
        if (sum == G) break;
        __builtin_amdgcn_s_sleep(1);
        if ((++sp & 255u) == 0u) { if (xb_ld(&bar[XB_TMO])) break; if (sp > XB_SPIN_CAP) { atomicAdd(&bar[XB_TMO], 1u); break; } }
    }
    nloc = mine > 0u ? mine : 1u; nx = cnt > 0u ? cnt : 1u;
}

__device__ __forceinline__ void xcd_barrier(const XcdBarrier& b) {
    asm volatile("s_waitcnt vmcnt(0)" ::: "memory");
    __syncthreads();
    if (threadIdx.x == 0) {
        unsigned* bar = b.bar;
        __builtin_amdgcn_s_waitcnt(0);
        unsigned nloc = b.st[0], nx = b.st[1];
        if (nloc == 0u) { xcd_barrier_complete(bar, b.x, nloc, nx); b.st[0] = nloc; b.st[1] = nx; }
        const unsigned old = xb_add(&bar[XB_XSUB(b.x)], 1u);
        const unsigned gen = old / nloc;
        if (old + 1u == (gen + 1u) * nloc) {
            __builtin_amdgcn_fence(__ATOMIC_RELEASE, "agent");
            asm volatile("s_waitcnt vmcnt(0)" ::: "memory");
            const unsigned og = xb_add(&bar[XB_TOP], 1u);
            const unsigned tg = og / nx;
            if (og + 1u == (tg + 1u) * nx) xb_add(&bar[XB_TOPGEN], 1u);
            else XB_SPIN(xb_ld(&bar[XB_TOPGEN]) == tg, bar);
            __builtin_amdgcn_fence(__ATOMIC_ACQUIRE, "agent");
            xb_add(&bar[XB_XGEN(b.x)], 1u);
            asm volatile("s_waitcnt vmcnt(0)" ::: "memory");
        } else {
            XB_SPIN(xb_ld(&bar[XB_XGEN(b.x)]) == gen, bar);
            __builtin_amdgcn_fence(__ATOMIC_ACQUIRE, "agent");
            asm volatile("s_waitcnt vmcnt(0)" ::: "memory");
        }
    }
    __syncthreads();
}

__device__ __forceinline__ void p0_transpose_item(const float* W, int K, int N, bf16* WT, int mode, LAS float* scr, int item, int lane) {
    const int nblk = N / 32, kb = item / nblk, nb = item % nblk, k0 = 64 * kb, n0 = 32 * nb;
#pragma unroll 32
    for (int i = 0; i < 32; ++i) { const int kk = 2 * i + (lane >> 5); scr[kk * 33 + (lane & 31)] = W[(size_t)(k0 + kk) * N + n0 + (lane & 31)]; }
    LDS_WAIT(); asm volatile("" ::: "memory");
    const int c = lane & 7;
#pragma unroll
    for (int j = 0; j < 4; ++j) { const int n = (lane >> 3) + 8 * j; const LAS float* s = scr + (8 * c) * 33 + n;
        v4u o; o.x = pk2(s[0 * 33], s[1 * 33]); o.y = pk2(s[2 * 33], s[3 * 33]); o.z = pk2(s[4 * 33], s[5 * 33]); o.w = pk2(s[6 * 33], s[7 * 33]);
        int dr = n0 + n;
        if (mode == 1) { const int isup = dr >= FF ? 1 : 0, jj = dr - isup * FF; dr = (jj >> 2) * 8 + isup * 4 + (jj & 3); }
        *(v4u*)(WT + (size_t)dr * K + k0 + 8 * c) = o; }
    LDS_WAIT(); asm volatile("" ::: "memory");
}
__device__ __forceinline__ bf16* wptr(const Args& a, int l, size_t off) { return (bf16*)(a.ws + WS_W + (size_t)l * W_LAYER + off); }
__device__ __forceinline__ float* modptr(const Args& a, int l) { return (float*)(a.ws + WS_MOD) + (size_t)l * 17 * NMOD * D; }

__device__ __forceinline__ void p0_prologue(const Args& a, const Blk& B) {
    LAS float* scr = (LAS float*)(B.lds + B.wave * 16384);
    const int gw = B.bid * NWAVES + B.wave, NGW = B.G * NWAVES;
    constexpr int I_GU = 16 * (NGU / 32), I_DN = (FF / 64) * (D / 32), I_IN0 = 16 * (NIN0 / 32), I_IN1 = 16 * (NIN1 / 32), I_OUT = 16 * 32;
    constexpr int PER0 = 2 * I_GU + 2 * I_DN + I_IN0 + I_OUT, PER1 = 2 * I_GU + 2 * I_DN + I_IN1 + I_OUT;
    for (int it = gw; it < PER0 + PER1; it += NGW) {
        const int l = it >= PER0 ? 1 : 0; int r = it - l * PER0; const int lo = l * LSTRIDE;
        if (r < 2 * I_GU) { const int s = r / I_GU; p0_transpose_item(a.in[I_GU0 + lo] + (size_t)s * D * NGU, D, NGU, wptr(a, l, W_GU) + (size_t)s * NGU * D, 1, scr, r % I_GU, B.lane); continue; } r -= 2 * I_GU;
        if (r < 2 * I_DN) { const int s = r / I_DN; p0_transpose_item(a.in[I_DN0 + lo] + (size_t)s * FF * D, FF, D, wptr(a, l, W_DN) + (size_t)s * D * FF, 0, scr, r % I_DN, B.lane); continue; } r -= 2 * I_DN;
        const int iin = l ? I_IN1 : I_IN0;
        if (r < iin) { p0_transpose_item(a.in[I_WIN0 + lo], D, l ? NIN1 : NIN0, wptr(a, l, W_IN), 0, scr, r, B.lane); continue; } r -= iin;
        p0_transpose_item(a.in[I_WOUT0 + lo], D, D, wptr(a, l, W_OUT), 0, scr, r, B.lane);
    }
    { bf16* lt = (bf16*)(a.ws + WS_LORA);
      for (int i = B.bid * 512 + B.tid; i < 2 * 512 * 64 * 2 + 512 * 128; i += B.G * 512) {
          if (i < 2 * 65536) { const int which = i >> 16, j = i & 65535, d = j >> 15, ch = (j >> 6) & 511, k = j & 63;
              lt[i] = f2bf(a.in[which ? I_A2 : I_W2][(size_t)d * 64 * 512 + (size_t)k * 512 + ch]); }
          else { const int j = i - 2 * 65536, ch = j >> 7, k = j & 127; lt[i] = f2bf(a.in[I_G2][(size_t)k * 512 + ch]); } } }
    __syncthreads();
    LAS float* SC = (LAS float*)B.lds;
    LAS float* PS = (LAS float*)(B.lds + 1024 * 20 * 4);
    bool have_sc = false;
    for (int u = B.bid; u < 288; u += B.G) {
        if (!have_sc) { for (int i = B.tid; i < 17 * 1024; i += 512) { const int s = i >> 10, k = i & 1023; const float c = s < 16 ? a.in[I_C][s * 1024 + k] : a.in[I_CCTX][k]; SC[k * 20 + s] = c * sigmoid_f(c); }
                        have_sc = true; __syncthreads(); }
        const int l = u / 144, cb = u % 144, col = cb * 64 + B.lane; const float* W = a.in[I_WMOD0 + l * LSTRIDE];
        float acc[17];
#pragma unroll
        for (int s = 0; s < 17; ++s) acc[s] = 0.f;
        const int kbeg = B.wave * 128;
#pragma unroll 16
        for (int k = kbeg; k < kbeg + 128; ++k) { const float w = W[(size_t)k * (NMOD * D) + col]; const LAS float* sc = SC + k * 20;
            const f32x4 s0 = *(const LAS f32x4*)(sc), s1 = *(const LAS f32x4*)(sc + 4), s2 = *(const LAS f32x4*)(sc + 8), s3 = *(const LAS f32x4*)(sc + 12); const float s4 = sc[16];
#pragma unroll
            for (int j = 0; j < 4; ++j) { acc[j] += s0[j] * w; acc[4 + j] += s1[j] * w; acc[8 + j] += s2[j] * w; acc[12 + j] += s3[j] * w; }
            acc[16] += s4 * w; }
#pragma unroll
        for (int s = 0; s < 17; ++s) PS[(B.wave * 17 + s) * 64 + B.lane] = acc[s];
        __syncthreads();
        for (int i = B.tid; i < 17 * 64; i += 512) { const int s = i >> 6, cc = i & 63; float t = 0.f;
#pragma unroll
            for (int w = 0; w < 8; ++w) t += PS[(w * 17 + s) * 64 + cc];
            const int n = cb * 64 + cc; modptr(a, l)[(size_t)s * (NMOD * D) + n] = t + a.in[I_BMOD0 + l * LSTRIDE][n]; }
        __syncthreads();
    }
}

__device__ __forceinline__ void p1_h0(const Args& a, const Blk& B) {
    const int gw = B.bid * NWAVES + B.wave, NGW = B.G * NWAVES; bf16* H = (bf16*)(a.ws + WS_H); const float* mod = modptr(a, 0);
    for (int row = gw; row < M_ALL; row += NGW) {
        const float* xr = row < M_LAT ? a.in[I_X] + (size_t)row * D : a.in[I_CTX] + (size_t)(row - M_LAT) * D; const int set = row < M_LAT ? row >> 11 : 16;
        const float* sh = mod + (size_t)(set * 9 + 0) * D, *sc = mod + (size_t)(set * 9 + 1) * D;
#pragma unroll
        for (int j = 0; j < 4; ++j) { const int c = 4 * B.lane + 256 * j; const f32x4 x = *(const f32x4*)(xr + c), s1 = *(const f32x4*)(sc + c), s0 = *(const f32x4*)(sh + c);
            const f32x4 h = x * (s1 + 1.0f) + s0; v2u o; o.x = pk2(h[0], h[1]); o.y = pk2(h[2], h[3]); *(v2u*)(H + (size_t)row * D + c) = o; }
    }
}
__device__ __forceinline__ void ln_phase(const Blk& B, float* xs_lat, float* xs_ctx, int nrows, const float* lng, const float* lnb, const float* mod, int i_shift, int i_scale, bf16* H) {
    const int gw = B.bid * NWAVES + B.wave, NGW = B.G * NWAVES;
    for (int row0 = gw; row0 < nrows; row0 += 2 * NGW) {
        const int row1 = row0 + NGW; const bool has1 = row1 < nrows; const int rr1 = has1 ? row1 : row0;
        float* xr0 = row0 < M_LAT ? xs_lat + (size_t)row0 * D : xs_ctx + (size_t)(row0 - M_LAT) * D; float* xr1 = rr1 < M_LAT ? xs_lat + (size_t)rr1 * D : xs_ctx + (size_t)(rr1 - M_LAT) * D;
        f32x4 v0[4], v1[4]; float s0 = 0.f, s1 = 0.f;
#pragma unroll
        for (int j = 0; j < 4; ++j) { v0[j] = *(const f32x4*)(xr0 + 4 * B.lane + 256 * j); v1[j] = *(const f32x4*)(xr1 + 4 * B.lane + 256 * j); }
#pragma unroll
        for (int j = 0; j < 4; ++j) { s0 += (v0[j][0] + v0[j][1]) + (v0[j][2] + v0[j][3]); s1 += (v1[j][0] + v1[j][1]) + (v1[j][2] + v1[j][3]); }
        const float mean0 = wave_sum(s0) * (1.f / D), mean1 = wave_sum(s1) * (1.f / D); float q0 = 0.f, q1 = 0.f;
#pragma unroll
        for (int j = 0; j < 4; ++j) { v0[j] = v0[j] - mean0; v1[j] = v1[j] - mean1; q0 += (v0[j][0] * v0[j][0] + v0[j][1] * v0[j][1]) + (v0[j][2] * v0[j][2] + v0[j][3] * v0[j][3]); q1 += (v1[j][0] * v1[j][0] + v1[j][1] * v1[j][1]) + (v1[j][2] * v1[j][2] + v1[j][3] * v1[j][3]); }
        const float rstd0 = 1.0f / sqrtf(wave_sum(q0) * (1.f / D) + LN_EPS), rstd1 = 1.0f / sqrtf(wave_sum(q1) * (1.f / D) + LN_EPS);
#pragma unroll
        for (int half = 0; half < 2; ++half) { if (half && !has1) break; const int row = half ? row1 : row0; float* xr = half ? xr1 : xr0; const float rstd = half ? rstd1 : rstd0; const int set = row < M_LAT ? row >> 11 : 16;
#pragma unroll
            for (int j = 0; j < 4; ++j) { const int c = 4 * B.lane + 256 * j; const f32x4 g = *(const f32x4*)(lng + c), bb = *(const f32x4*)(lnb + c);
                const f32x4 x = (half ? v1[j] : v0[j]) * rstd * g + bb; *(f32x4*)(xr + c) = x;
                if (mod) { const f32x4 sc1 = *(const f32x4*)(mod + (size_t)(set * 9 + i_scale) * D + c), sh0 = *(const f32x4*)(mod + (size_t)(set * 9 + i_shift) * D + c);
                    const f32x4 h = x * (sc1 + 1.0f) + sh0; v2u o; o.x = pk2(h[0], h[1]); o.y = pk2(h[2], h[3]); *(v2u*)(H + (size_t)row * D + c) = o; } } }
    }
}

__device__ __forceinline__ void ln_dummy(const Blk& B, const float* xs_lat, const float* xs_ctx, int nrows, const float* lng, const float* lnb, const float* mod, int i_shift, int i_scale, float* XD, bf16* HD) {
    const int gw = B.bid * NWAVES + B.wave, NGW = B.G * NWAVES;
    for (int row = gw; row < nrows; row += NGW) {
        const float* xr = row < M_LAT ? xs_lat + (size_t)row * D : xs_ctx + (size_t)(row - M_LAT) * D; const int set = row < M_LAT ? row >> 11 : 16;
        f32x4 v[4]; float s = 0.f;
#pragma unroll
        for (int j = 0; j < 4; ++j) { v[j] = *(const f32x4*)(xr + 4 * B.lane + 256 * j); s += (v[j][0] + v[j][1]) + (v[j][2] + v[j][3]); }
        const float mean = wave_sum(s) * (1.f / D); float s2 = 0.f;
#pragma unroll
        for (int j = 0; j < 4; ++j) { v[j] = v[j] - mean; s2 += (v[j][0] * v[j][0] + v[j][1] * v[j][1]) + (v[j][2] * v[j][2] + v[j][3] * v[j][3]); }
        const float rstd = 1.0f / sqrtf(wave_sum(s2) * (1.f / D) + LN_EPS);
#pragma unroll
        for (int j = 0; j < 4; ++j) { const int c = 4 * B.lane + 256 * j; const f32x4 g = *(const f32x4*)(lng + c), bb = *(const f32x4*)(lnb + c);
            const f32x4 x = v[j] * rstd * g + bb; *(f32x4*)(XD + (size_t)row * D + c) = x;
            const f32x4 s1 = *(const f32x4*)(mod + (size_t)(set * 9 + i_scale) * D + c), s0 = *(const f32x4*)(mod + (size_t)(set * 9 + i_shift) * D + c);
            const f32x4 h = x * (s1 + 1.0f) + s0; v2u o; o.x = pk2(h[0], h[1]); o.y = pk2(h[2], h[3]); *(v2u*)(HD + (size_t)row * D + c) = o; }
    }
}

template <int DV> __device__ __forceinline__ void vt_build(const Blk& B, const bf16* U, int pitch, int colbase, int NH, bf16* VT) {
    constexpr int LP = DV + 8;
    LAS bf16* scr = (LAS bf16*)(B.lds + B.wave * (64 * LP * 2));
    const int gw = B.bid * NWAVES + B.wave, NGW = B.G * NWAVES, nunits = NB * NH * (NKEY / 64);
    for (int u = gw; u < nunits; u += NGW) {
        const int kt = u % (NKEY / 64), bh = u / (NKEY / 64), b = bh / NH, hs = bh % NH, key = kt * 64 + B.lane;
        const size_t row = key < SEQ ? (size_t)b * SEQ + key : (size_t)M_LAT + b * CTXL + (key - SEQ);
        const bf16* src = U + row * pitch + colbase + hs * DV;
#pragma unroll
        for (int i = 0; i < DV / 8; ++i) *(LAS v4u*)(scr + B.lane * LP + 8 * i) = *(const v4u*)(src + 8 * i);
        LDS_WAIT(); asm volatile("" ::: "memory");
#pragma unroll
        for (int p = 0; p < DV / 64; ++p) { const int dv = p * 64 + B.lane; bf16* dst = VT + ((size_t)bh * DV + dv) * NKEY + kt * 64;
#pragma unroll
            for (int c = 0; c < 8; ++c) { unsigned w[4];
#pragma unroll
                for (int e = 0; e < 4; ++e) { const unsigned lo = scr[(8 * c + 2 * e) * LP + dv], hi = scr[(8 * c + 2 * e + 1) * LP + dv]; w[e] = lo | (hi << 16); }
                v4u o; o.x = w[0]; o.y = w[1]; o.z = w[2]; o.w = w[3]; *(v4u*)(dst + 8 * c) = o; } }
        LDS_WAIT(); asm volatile("" ::: "memory");
    }
}

__device__ __forceinline__ f32x16 qk_tile(const bf16* krow, const bf16x8 (&qf)[4], int hh) {
    f32x16 s;
#pragma unroll
    for (int e = 0; e < 16; ++e) s[e] = 0.f;
#pragma unroll
    for (int ks = 0; ks < 4; ++ks) { const bf16x8 kf = *(const bf16x8*)(krow + 16 * ks + 8 * hh); s = MFMA32(kf, qf[ks], s); }
    return s;
}
constexpr float SM_THR = 4.0f;
__device__ __forceinline__ void sm_update(f32x16& s, float& m, float& l, float& alpha, bf16x8& p0, bf16x8& p1, bool& resc) {
    float tm = s[0];
#pragma unroll
    for (int e = 1; e < 16; ++e) tm = fmaxf(tm, s[e]);
    tm = xhalf_max(tm);
    resc = !__all(tm - m <= SM_THR);
    float mn = m; alpha = 1.0f;
    if (resc) { mn = fmaxf(m, tm); alpha = __expf(m - mn); m = mn; l *= alpha; }
    float ps = 0.f;
#pragma unroll
    for (int e = 0; e < 16; ++e) { s[e] = __expf(s[e] - mn); ps += s[e]; }
    l += ps;
    v4u a, b; a.x = pk2(s[0], s[1]); a.y = pk2(s[2], s[3]); a.z = pk2(s[4], s[5]); a.w = pk2(s[6], s[7]); b.x = pk2(s[8], s[9]); b.y = pk2(s[10], s[11]); b.z = pk2(s[12], s[13]); b.w = pk2(s[14], s[15]);
    p0 = __builtin_bit_cast(bf16x8, a); p1 = __builtin_bit_cast(bf16x8, b);
}
__device__ __forceinline__ bf16x8 vt_frag(const bf16* vrow, int ks, int hh) {
    const v2u lo = *(const v2u*)(vrow + 16 * ks + 4 * hh), hi = *(const v2u*)(vrow + 16 * ks + 8 + 4 * hh);
    v4u w; w.x = lo.x; w.y = lo.y; w.z = hi.x; w.w = hi.y; return __builtin_bit_cast(bf16x8, w);
}

__device__ __forceinline__ void na_phase(const Args& a, const Blk& B) {
    const bf16* UB = (const bf16*)(a.ws + WS_R3); const bf16* VT = (const bf16*)(a.ws + WS_VT0); bf16* YM = (bf16*)(a.ws + WS_H);
    LAS float* rpb = (LAS float*)B.lds;
    for (int i = B.tid; i < 8 * 15 * 31; i += 512) rpb[i] = a.in[I_RPB][i];
    __syncthreads();
    const int gw = B.bid * NWAVES + B.wave, NGW = B.G * NWAVES, r32 = B.lane & 31, hh = B.lane >> 5;
    constexpr int NLAT = NB * 8 * 32 * 2, NCTX = NB * 8 * 8;
    for (int u = gw; u < NLAT + NCTX; u += NGW) {
        const bool lat = u < NLAT; int b, h, r = 0, g = 0, tile = 0;
        if (lat) { g = u & 1; r = (u >> 1) & 31; h = (u >> 6) & 7; b = u >> 9; } else { const int v = u - NLAT; tile = v & 7; h = (v >> 3) & 7; b = v >> 6; }
        const size_t qrow = lat ? (size_t)b * SEQ + r * 64 + 32 * g + r32 : (size_t)M_LAT + b * CTXL + tile * 32 + r32;
        bf16x8 qf[4];
#pragma unroll
        for (int ks = 0; ks < 4; ++ks) qf[ks] = *(const bf16x8*)(UB + qrow * UB_LD + h * 64 + 16 * ks + 8 * hh);
        f32x16 O0, O1;
#pragma unroll
        for (int e = 0; e < 16; ++e) { O0[e] = 0.f; O1[e] = 0.f; }
        float m = -1e30f, l = 0.f;
        const bf16* vbase = VT + ((size_t)(b * 8 + h) * 64 + r32) * NKEY;
        for (int c = 0; c < ((DBG_NA_NOCTX && lat) ? 0 : 8); ++c) {
            const size_t krow = (size_t)M_LAT + b * CTXL + 32 * c + r32;
            f32x16 s = qk_tile(UB + krow * UB_LD + 512 + h * 64, qf, hh);
            float alpha; bf16x8 p0, p1; bool resc; sm_update(s, m, l, alpha, p0, p1, resc);
            if (resc) {
#pragma unroll
            for (int e = 0; e < 16; ++e) { O0[e] *= alpha; O1[e] *= alpha; } }
            const bf16* v0 = vbase + SEQ + 32 * c; const bf16* v1 = v0 + (size_t)32 * NKEY;
            O0 = MFMA32(vt_frag(v0, 0, hh), p0, O0); O0 = MFMA32(vt_frag(v0, 1, hh), p1, O0);
            O1 = MFMA32(vt_frag(v1, 0, hh), p0, O1); O1 = MFMA32(vt_frag(v1, 1, hh), p1, O1);
        }
        if (lat && !DBG_NA_NOLOCAL) {
            const int rs = min(max(r - 4, 0), 24), qc = 32 * g + r32, cs = min(max(qc - 8, 0), 48);
            for (int i = 0; i < 8; ++i) for (int cg = 0; cg < 2; ++cg) {
                const int kr = rs + i, ktok = kr * 64 + 32 * cg;
                const size_t krow = (size_t)b * SEQ + ktok + r32;
                f32x16 s = qk_tile(UB + krow * UB_LD + 512 + h * 64, qf, hh);
                const LAS float* bias = rpb + (h * 15 + (kr - r + 7)) * 31;
#pragma unroll
                for (int e = 0; e < 16; ++e) { const int kc = 32 * cg + (e & 3) + 8 * (e >> 2) + 4 * hh; const bool ok = (kc >= cs) && (kc < cs + 16); const int dc = min(max(kc - qc + 15, 0), 30);
                    s[e] = ok ? s[e] + (DBG_NA_NOBIAS ? 0.f : bias[dc]) : -1e30f; }
                float alpha; bf16x8 p0, p1; bool resc; sm_update(s, m, l, alpha, p0, p1, resc);
                if (resc) {
#pragma unroll
                for (int e = 0; e < 16; ++e) { O0[e] *= alpha; O1[e] *= alpha; } }
                const bf16* v0 = vbase + ktok; const bf16* v1 = v0 + (size_t)32 * NKEY;
                O0 = MFMA32(vt_frag(v0, 0, hh), p0, O0); O0 = MFMA32(vt_frag(v0, 1, hh), p1, O0);
                O1 = MFMA32(vt_frag(v1, 0, hh), p0, O1); O1 = MFMA32(vt_frag(v1, 1, hh), p1, O1);
            }
        }
        const float inv = (DBG_Z_NA || DBG_HZ_NA(h)) ? 0.f : DBG_S_NA / xhalf_sum(l);
        bf16* yo = YM + qrow * D + 512 + h * 64 + 4 * hh;
#pragma unroll
        for (int eg = 0; eg < 4; ++eg) { v2u o; o.x = pk2(O0[4 * eg] * inv, O0[4 * eg + 1] * inv); o.y = pk2(O0[4 * eg + 2] * inv, O0[4 * eg + 3] * inv); *(v2u*)(yo + 8 * eg) = o;
            v2u q; q.x = pk2(O1[4 * eg] * inv, O1[4 * eg + 1] * inv); q.y = pk2(O1[4 * eg + 2] * inv, O1[4 * eg + 3] * inv); *(v2u*)(yo + 32 + 8 * eg) = q; }
    }
}

__device__ __forceinline__ void ush8(const bf16* UA, size_t row, int c0, bool hp, bool hn, const float* mu, float (&o)[8]) {
    const v4u u0 = *(const v4u*)(UA + row * UA_LD + c0); v4u up, un;
    if (hp) up = *(const v4u*)(UA + (row - 1) * UA_LD + c0); else { up.x = 0; up.y = 0; up.z = 0; up.w = 0; }
    if (hn) un = *(const v4u*)(UA + (row + 1) * UA_LD + c0); else { un.x = 0; un.y = 0; un.z = 0; un.w = 0; }
    const f32x4 m0 = *(const f32x4*)(mu + c0) * DBG_MUS, m1 = *(const f32x4*)(mu + c0 + 4) * DBG_MUS;
    const unsigned a[4] = {u0.x, u0.y, u0.z, u0.w}, p[4] = {up.x, up.y, up.z, up.w}, n[4] = {un.x, un.y, un.z, un.w};
#pragma unroll
    for (int e = 0; e < 4; ++e) { const float x0 = bflo(a[e]), x1 = bfhi(a[e]); const float mm0 = e < 2 ? m0[2 * e] : m1[2 * e - 4], mm1 = e < 2 ? m0[2 * e + 1] : m1[2 * e - 3];
        o[2 * e] = x0 + mm0 * (0.5f * (bflo(p[e]) + bflo(n[e])) - x0); o[2 * e + 1] = x1 + mm1 * (0.5f * (bfhi(p[e]) + bfhi(n[e])) - x1); }
}
__device__ __forceinline__ void ush4(const bf16* UA, size_t row, int c0, bool hp, bool hn, const float* mu, float (&o)[4]) {
    const v2u u0 = *(const v2u*)(UA + row * UA_LD + c0); v2u up, un;
    if (hp) up = *(const v2u*)(UA + (row - 1) * UA_LD + c0); else { up.x = 0; up.y = 0; }
    if (hn) un = *(const v2u*)(UA + (row + 1) * UA_LD + c0); else { un.x = 0; un.y = 0; }
    const f32x4 m0 = *(const f32x4*)(mu + c0) * DBG_MUS;
    o[0] = bflo(u0.x) + m0[0] * (0.5f * (bflo(up.x) + bflo(un.x)) - bflo(u0.x)); o[1] = bfhi(u0.x) + m0[1] * (0.5f * (bfhi(up.x) + bfhi(un.x)) - bfhi(u0.x));
    o[2] = bflo(u0.y) + m0[2] * (0.5f * (bflo(up.y) + bflo(un.y)) - bflo(u0.y)); o[3] = bfhi(u0.y) + m0[3] * (0.5f * (bfhi(up.y) + bfhi(un.y)) - bfhi(u0.y));
}
__device__ __forceinline__ float ush1(const bf16* UA, size_t row, int c, bool hp, bool hn, const float* mu) {
    const float x0 = bf2f(UA[row * UA_LD + c]), xp = hp ? bf2f(UA[(row - 1) * UA_LD + c]) : 0.f, xn = hn ? bf2f(UA[(row + 1) * UA_LD + c]) : 0.f;
    return x0 + mu[c] * DBG_MUS * (0.5f * (xp + xn) - x0);
}
__device__ __forceinline__ void reduce8(const float (&x)[8], int lane, float& e0, float& e1) {
    float c[4];
#pragma unroll
    for (int i = 0; i < 4; ++i) { auto rr = __builtin_amdgcn_permlane32_swap(__float_as_uint(x[i]), __float_as_uint(x[i + 4]), false, false); c[i] = __uint_as_float(rr[0]) + __uint_as_float(rr[1]); }
    const bool odd = (lane >> 4) & 1;
    const float k0 = odd ? c[2] : c[0], s0 = odd ? c[0] : c[2], k1 = odd ? c[3] : c[1], s1 = odd ? c[1] : c[3];
    e0 = row16_sum(k0 + __shfl_xor(s0, 16)); e1 = row16_sum(k1 + __shfl_xor(s1, 16));
}

#define RW_GEOM(sg_, isctx_, T_, t0_, rowbase_) const bool isctx_ = (sg_) < 8; const int T_ = isctx_ ? CTXL : SEQ, t0_ = (isctx_ ? (dir ? 7 - (sg_) : (sg_)) : (dir ? 71 - (sg_) : (sg_) - 8)) * 32; \
    const size_t rowbase_ = isctx_ ? (size_t)M_LAT + b * CTXL : (size_t)b * SEQ
__device__ __forceinline__ void rwkv_scan_phase(const Args& a, const Blk& B) {
    const bf16* UA = (const bf16*)(a.ws + WS_R2); float* Y = (float*)(a.ws + WS_Y); const bf16* lora = (const bf16*)(a.ws + WS_LORA);
    LAS float* OPS = (LAS float*)B.lds; LAS float* VV = (LAS float*)(B.lds + 40960); LAS float* LW = (LAS float*)(B.lds + 49152); LAS float* LA = (LAS float*)(B.lds + 57344);
    const float* mu = a.in[I_MU]; const int r32 = B.lane & 31, hh = B.lane >> 5, lane = B.lane;
    for (int scan = B.bid; scan < 256; scan += B.G) {
        const int dir = scan & 1, h = (scan >> 1) & 7, b = scan >> 4, hc = h * 64 + lane;
        float S[8];
#pragma unroll
        for (int i = 0; i < 8; ++i) S[i] = 0.f;
        const float w0v = a.in[I_W0][dir * 512 + hc], a0v = a.in[I_A0][dir * 512 + hc], kkv = a.in[I_KK][hc], kav = a.in[I_KA][hc];
        const float mur = mu[hc], muk = mu[512 + hc], muv = mu[1024 + hc];
        const int which = B.wave & 1, colin = (which ? 1664 : 1536) + 64 * dir;
        unsigned pu[6][3]; v4u lx[4][3];
#define RW_PREFETCH(sg_) do { RW_GEOM(sg_, pc_, pT_, pt0_, prb_); (void)pc_; \
            _Pragma("unroll") for (int i = 0; i < 6; ++i) { int tt_ = pt0_ + 4 * B.wave - 1 + i; tt_ = tt_ < 0 ? 0 : (tt_ > pT_ - 1 ? pT_ - 1 : tt_); const bf16* p_ = UA + (prb_ + tt_) * UA_LD + hc; pu[i][0] = p_[0]; pu[i][1] = p_[512]; pu[i][2] = p_[1024]; } \
            if (B.wave < 2) { const int t_ = pt0_ + r32; const int tp_ = t_ > 0 ? t_ - 1 : t_, tn_ = t_ < pT_ - 1 ? t_ + 1 : t_; \
                _Pragma("unroll") for (int ks = 0; ks < 4; ++ks) { const int c_ = colin + 16 * ks + 8 * hh; lx[ks][0] = *(const v4u*)(UA + (prb_ + t_) * UA_LD + c_); lx[ks][1] = *(const v4u*)(UA + (prb_ + tp_) * UA_LD + c_); lx[ks][2] = *(const v4u*)(UA + (prb_ + tn_) * UA_LD + c_); } } } while (0)
        RW_PREFETCH(0);
        for (int sg = 0; sg < 72; ++sg) {
            RW_GEOM(sg, isctx, T, t0, rowbase); (void)isctx;
            if (B.wave < 2) {
                const bf16* wT = lora + (size_t)which * 65536 + (size_t)(dir * 512 + h * 64) * 64;
                const int t = t0 + r32; const bool hp = t > 0, hn = t < T - 1; bf16x8 bfr[4];
#pragma unroll
                for (int ks = 0; ks < 4; ++ks) { const int c0 = colin + 16 * ks + 8 * hh; const f32x4 m0 = *(const f32x4*)(mu + c0), m1 = *(const f32x4*)(mu + c0 + 4);
                    const unsigned ua[4] = {lx[ks][0].x, lx[ks][0].y, lx[ks][0].z, lx[ks][0].w}, up[4] = {lx[ks][1].x, lx[ks][1].y, lx[ks][1].z, lx[ks][1].w}, un[4] = {lx[ks][2].x, lx[ks][2].y, lx[ks][2].z, lx[ks][2].w};
                    float x[8];
#pragma unroll
                    for (int e = 0; e < 4; ++e) { const float x0 = bflo(ua[e]), x1 = bfhi(ua[e]), p0 = hp ? bflo(up[e]) : 0.f, p1 = hp ? bfhi(up[e]) : 0.f, n0 = hn ? bflo(un[e]) : 0.f, n1 = hn ? bfhi(un[e]) : 0.f;
                        const float mm0 = e < 2 ? m0[2 * e] : m1[2 * e - 4], mm1 = e < 2 ? m0[2 * e + 1] : m1[2 * e - 3];
                        x[2 * e] = x0 + mm0 * (0.5f * (p0 + n0) - x0); x[2 * e + 1] = x1 + mm1 * (0.5f * (p1 + n1) - x1); }
                    if (!which) {
#pragma unroll
                        for (int e = 0; e < 8; ++e) x[e] = 1.0f - 2.0f * __builtin_amdgcn_rcpf(1.0f + __expf(2.0f * x[e])); }
                    v4u w; w.x = pk2(x[0], x[1]); w.y = pk2(x[2], x[3]); w.z = pk2(x[4], x[5]); w.w = pk2(x[6], x[7]); bfr[ks] = __builtin_bit_cast(bf16x8, w); }
#pragma unroll
                for (int tl = 0; tl < 2; ++tl) { f32x16 acc;
#pragma unroll
                    for (int e = 0; e < 16; ++e) acc[e] = 0.f;
#pragma unroll
                    for (int ks = 0; ks < 4; ++ks) { const bf16x8 af = *(const bf16x8*)(wT + (size_t)(32 * tl + r32) * 64 + 16 * ks + 8 * hh); acc = MFMA32(af, bfr[ks], acc); }
                    LAS float* dst = (which ? LA : LW) + r32 * 64 + 32 * tl + 4 * hh;
#pragma unroll
                    for (int eg = 0; eg < 4; ++eg) { f32x4 o; o[0] = acc[4 * eg]; o[1] = acc[4 * eg + 1]; o[2] = acc[4 * eg + 2]; o[3] = acc[4 * eg + 3]; *(LAS f32x4*)(dst + 8 * eg) = o; } }
            }
            float r4[4], k4[4], v4[4], kk4[4];
#pragma unroll
            for (int jj = 0; jj < 4; ++jj) { const int t = t0 + 4 * B.wave + jj; const bool hp = t > 0, hn = t < T - 1;
                const float r0 = bf2f((bf16)pu[jj + 1][0]), k0 = bf2f((bf16)pu[jj + 1][1]), v0 = bf2f((bf16)pu[jj + 1][2]);
                const float rp = hp ? bf2f((bf16)pu[jj][0]) : 0.f, kp = hp ? bf2f((bf16)pu[jj][1]) : 0.f, vp = hp ? bf2f((bf16)pu[jj][2]) : 0.f;
                const float rn = hn ? bf2f((bf16)pu[jj + 2][0]) : 0.f, kn = hn ? bf2f((bf16)pu[jj + 2][1]) : 0.f, vn = hn ? bf2f((bf16)pu[jj + 2][2]) : 0.f;
                r4[jj] = r0 + mur * (0.5f * (rp + rn) - r0); k4[jj] = k0 + muk * (0.5f * (kp + kn) - k0); v4[jj] = v0 + muv * (0.5f * (vp + vn) - v0);
                const float kkr = k4[jj] * kkv, n2 = wave_sum(kkr * kkr); kk4[jj] = kkr / fmaxf(sqrtf(n2), 1e-12f); }
            __syncthreads();
#pragma unroll
            for (int jj = 0; jj < 4; ++jj) { const int j = 4 * B.wave + jj;
                const float wl = w0v + (DBG_NOLW ? 0.f : LW[j * 64 + lane]), w = __expf(-0.60653066f * sigmoid_f(wl)), aa = sigmoid_f(a0v + (DBG_NOLA ? 0.f : LA[j * 64 + lane]));
                LAS float* op = OPS + j * 320 + (lane & 15) * 4 + (lane >> 4);
                op[0] = kk4[jj]; op[64] = w; op[128] = kk4[jj] * aa; op[192] = k4[jj] * (1.0f + (aa - 1.0f) * kav); op[256] = r4[jj]; VV[j * 64 + lane] = v4[jj]; }
            __syncthreads();
            if (sg + 1 < 72) RW_PREFETCH(sg + 1);
            { const int g = lane >> 4, c16 = lane & 15;
              for (int jj = 0; jj < 32; ++jj) { const int j = dir ? 31 - jj : jj; const LAS float* op = OPS + j * 320 + c16 * 4;
                const f32x4 kk = *(const LAS f32x4*)(op), w = *(const LAS f32x4*)(op + 64), kka = *(const LAS f32x4*)(op + 128), kt = *(const LAS f32x4*)(op + 192), rr = *(const LAS f32x4*)(op + 256);
                const f32x2 vv = *(const LAS f32x2*)(VV + j * 64 + 8 * B.wave + 2 * g);
                float p0 = (S[0] * kk[0] + S[1] * kk[1]) + (S[2] * kk[2] + S[3] * kk[3]), p1 = (S[4] * kk[0] + S[5] * kk[1]) + (S[6] * kk[2] + S[7] * kk[3]);
                const float sk0 = row16_sum(p0), sk1 = row16_sum(p1);
#pragma unroll
                for (int q = 0; q < 4; ++q) { S[q] = S[q] * w[q] - sk0 * kka[q] + vv[0] * kt[q]; S[4 + q] = S[4 + q] * w[q] - sk1 * kka[q] + vv[1] * kt[q]; }
                float q0 = (S[0] * rr[0] + S[1] * rr[1]) + (S[2] * rr[2] + S[3] * rr[3]), q1 = (S[4] * rr[0] + S[5] * rr[1]) + (S[6] * rr[2] + S[7] * rr[3]);
                q0 = row16_sum(q0); q1 = row16_sum(q1);
                if (c16 == 0) { const size_t row = rowbase + t0 + j; const int ch = h * 64 + 8 * B.wave + 2 * g; f32x2 o2; o2[0] = q0; o2[1] = q1; *(f32x2*)(Y + ((size_t)dir * M_ALL + row) * 512 + ch) = o2; }
              } }
        }
#undef RW_PREFETCH
    }
}
#undef RW_GEOM
__device__ __forceinline__ v2u ldg8(const void* base, unsigned boff) { return *(const v2u*)((const char*)base + boff); }
__device__ __forceinline__ f32x4 ldg16f(const void* base, unsigned boff) { return *(const f32x4*)((const char*)base + boff); }
__device__ __forceinline__ void ush4o(const bf16* UA, unsigned boff, bool hp, bool hn, const f32x4 m0_, float (&o)[4]) { const f32x4 m0 = m0_ * DBG_MUS;
    const v2u u0 = ldg8(UA, boff); v2u up = ldg8(UA, hp ? boff - UA_LD * 2 : boff), un = ldg8(UA, hn ? boff + UA_LD * 2 : boff);
    if (!hp) { up.x = 0; up.y = 0; } if (!hn) { un.x = 0; un.y = 0; }
    o[0] = bflo(u0.x) + m0[0] * (0.5f * (bflo(up.x) + bflo(un.x)) - bflo(u0.x)); o[1] = bfhi(u0.x) + m0[1] * (0.5f * (bfhi(up.x) + bfhi(un.x)) - bfhi(u0.x));
    o[2] = bflo(u0.y) + m0[2] * (0.5f * (bflo(up.y) + bflo(un.y)) - bflo(u0.y)); o[3] = bfhi(u0.y) + m0[3] * (0.5f * (bfhi(up.y) + bfhi(un.y)) - bfhi(u0.y));
}
__device__ __forceinline__ void rwkv_post_phase(const Args& a, const Blk& B) {
    const bf16* UA = (const bf16*)(a.ws + WS_R2); const float* Y = (const float*)(a.ws + WS_Y); const bf16* g2T = (const bf16*)(a.ws + WS_LORA) + 2 * 65536; bf16* YM = (bf16*)(a.ws + WS_H);
    const float* mu = a.in[I_MU]; const float* RK = a.in[I_RK]; const float* GNG = a.in[I_GNG]; const float* GNB = a.in[I_GNB];
    const int gw = B.bid * NWAVES + B.wave, NGW = B.G * NWAVES, r32 = B.lane & 31, hh = B.lane >> 5;
#pragma unroll 1
    for (int tile = gw; tile < M_ALL / 32; tile += NGW) {
        const unsigned row = (unsigned)tile * 32 + r32; const bool isctx = row >= (unsigned)M_LAT; const int t = isctx ? (int)((row - M_LAT) & (CTXL - 1)) : (int)(row & (SEQ - 1)), T = isctx ? CTXL : SEQ;
        const bool hp = t > 0, hn = t < T - 1;
        bf16x8 bg[8];
#pragma unroll
        for (int ks = 0; ks < 8; ++ks) { float x[8]; ush8(UA, row, 1792 + 16 * ks + 8 * hh, hp, hn, mu, x);
            v4u w; w.x = pk2(sigmoid_f(x[0]), sigmoid_f(x[1])); w.y = pk2(sigmoid_f(x[2]), sigmoid_f(x[3])); w.z = pk2(sigmoid_f(x[4]), sigmoid_f(x[5])); w.w = pk2(sigmoid_f(x[6]), sigmoid_f(x[7])); bg[ks] = __builtin_bit_cast(bf16x8, w); }
#pragma unroll 1
        for (int hd = 0; hd < 8; ++hd) {
            const unsigned chb = 64 * hd + 4 * hh;
            const unsigned uo = row * (UA_LD * 2) + chb * 2, yo = row * 2048 + chb * 4, po = chb * 4;
            float y[32], rkp = 0.f, ys = 0.f;
#pragma unroll
            for (int q = 0; q < 8; ++q) { const unsigned co = 32 * (q >> 2) + 8 * (q & 3);
                const f32x4 yf = ldg16f(Y, yo + co * 4), yb = ldg16f(Y + (size_t)M_ALL * 512, yo + co * 4);
                { const float cf = DBG_NOYF ? 0.f : 1.f, cb = DBG_NOYB ? 0.f : 1.f; y[4 * q] = cf * yf[0] + cb * yb[0]; y[4 * q + 1] = cf * yf[1] + cb * yb[1]; y[4 * q + 2] = cf * yf[2] + cb * yb[2]; y[4 * q + 3] = cf * yf[3] + cb * yb[3]; }
                ys += (y[4 * q] + y[4 * q + 1]) + (y[4 * q + 2] + y[4 * q + 3]);
                float rr[4], kk[4]; ush4o(UA, uo + co * 2, hp, hn, ldg16f(mu, po + co * 4), rr); ush4o(UA, uo + (512 + co) * 2, hp, hn, ldg16f(mu + 512, po + co * 4), kk); const f32x4 rk = ldg16f(RK, po + co * 4);
                rkp += rr[0] * kk[0] * rk[0] + rr[1] * kk[1] * rk[1] + rr[2] * kk[2] * rk[2] + rr[3] * kk[3] * rk[3]; }
            const float mean = xhalf_sum(ys) * (1.0f / 64.0f); float q2 = 0.f;
#pragma unroll
            for (int e = 0; e < 32; ++e) { y[e] -= mean; q2 += y[e] * y[e]; }
            const float rstd = 1.0f / sqrtf(xhalf_sum(q2) * (1.0f / 64.0f) + GN_EPS), rks = DBG_NOBONUS ? 0.f : xhalf_sum(rkp);
#pragma unroll
            for (int tl = 0; tl < 2; ++tl) {
                f32x16 g0;
#pragma unroll
                for (int e = 0; e < 16; ++e) g0[e] = 0.f;
#pragma unroll
                for (int ks = 0; ks < 8; ++ks) { const bf16x8 a0 = *(const bf16x8*)((const char*)g2T + (unsigned)(((64 * hd + 32 * tl + r32) * 128 + 16 * ks + 8 * hh) * 2)); g0 = MFMA32(a0, bg[ks], g0); }
#pragma unroll
                for (int eg = 0; eg < 4; ++eg) { const unsigned co = 32 * tl + 8 * eg; float vv[4]; ush4o(UA, uo + (1024 + co) * 2, hp, hn, ldg16f(mu + 1024, po + co * 4), vv);
                    const f32x4 gg = ldg16f(GNG, po + co * 4), gb = ldg16f(GNB, po + co * 4); float o[4];
#pragma unroll
                    for (int e = 0; e < 4; ++e) o[e] = (DBG_Z_RWKV || DBG_HZ_RWKV(hd)) ? 0.f : DBG_S_RWKV * (y[16 * tl + 4 * eg + e] * rstd * gg[e] + gb[e] + rks * vv[e]) * g0[4 * eg + e];
                    v2u w; w.x = pk2(o[0], o[1]); w.y = pk2(o[2], o[3]); *(v2u*)((char*)YM + (row * 2048u + (chb + co) * 2)) = w; }
            }
        }
    }
}


__device__ __forceinline__ void rope_phase(const Args& a, const Blk& B) {
    bf16* U1 = (bf16*)(a.ws + WS_R2); const int gw = B.bid * NWAVES + B.wave, NGW = B.G * NWAVES;
    const int i = B.lane & 15, seg = (B.lane >> 4) & 1, vpar = B.lane >> 5; const float freq = powf(10000.0f, -(float)i * (1.0f / 16.0f));
    for (int row = gw; row < M_LAT; row += NGW) {
        const int t = row & (SEQ - 1), pos = (DBG_ROPE == 2 ? !seg : seg) ? (t & 63) : (t >> 6); float sn, cs; sincosf((float)pos * freq * (DBG_ROPE == 3 ? -1.f : 1.f), &sn, &cs); if (DBG_ROPE == 1) { sn = 0.f; cs = 1.f; }
        bf16* ur = U1 + (size_t)row * U1_LD;
#pragma unroll
        for (int it = 0; it < 8; ++it) { const int v = 2 * it + vpar, c0 = (v < 8 ? 1568 + v * 64 : 2080 + (v - 8) * 64) + 32 * seg + i;
            const float x1 = bf2f(ur[c0]), x2 = bf2f(ur[c0 + 16]); ur[c0] = f2bf(x1 * cs - x2 * sn); ur[c0 + 16] = f2bf(x2 * cs + x1 * sn); }
    }
}

constexpr int DK_P = 136, DV_P = 36;
constexpr int DF_K0 = 0, DF_K1 = 32 * DK_P * 2, DF_V0 = 2 * 32 * DK_P * 2, DF_V1 = DF_V0 + 128 * DV_P * 2, DF_Q = DF_V1 + 128 * DV_P * 2;
__device__ __forceinline__ void diff_block(const Args& a, const Blk& B, int b, int hd, int qblk, float lam) {
    const bf16* U1 = (const bf16*)(a.ws + WS_R2); const bf16* VT = (const bf16*)(a.ws + WS_VT1); bf16* YM = (bf16*)(a.ws + WS_H);
    const int r32 = B.lane & 31, hh = B.lane >> 5; const size_t qrow = (size_t)b * SEQ + (qblk * 8 + B.wave) * 32 + r32;
    LAS bf16* Qs = (LAS bf16*)(B.lds + DF_Q + B.wave * (32 * DK_P * 2));
#pragma unroll
    for (int c = 0; c < 8; ++c) *(LAS v4u*)(Qs + r32 * DK_P + 16 * c + 8 * hh) = *(const v4u*)(U1 + qrow * U1_LD + 1568 + hd * 128 + 16 * c + 8 * hh);
    f32x16 Oa[4], Ob[4];
#pragma unroll
    for (int d = 0; d < 4; ++d)
#pragma unroll
        for (int e = 0; e < 16; ++e) { Oa[d][e] = 0.f; Ob[d][e] = 0.f; }
    float m0 = -1e30f, l0 = 0.f, m1 = -1e30f, l1 = 0.f;
    const int skey = B.tid >> 4, skc = B.tid & 15, sdv = B.tid >> 2, svc = B.tid & 3;
    const bf16* vsrc = VT + ((size_t)(b * 4 + hd) * 128 + sdv) * NKEY + 8 * svc;
    const unsigned kdst = (unsigned)(skey * DK_P + 8 * skc) * 2u, vdst = (unsigned)(sdv * DV_P + 8 * svc) * 2u;
    v4u kreg, vreg;
#define DF_LOAD(kt) do { const int ki_ = 32 * (kt) + skey; const size_t kr_ = ki_ < SEQ ? (size_t)b * SEQ + ki_ : (size_t)M_LAT + b * CTXL + (ki_ - SEQ); \
        kreg = *(const v4u*)(U1 + kr_ * U1_LD + 2080 + hd * 128 + 8 * skc); vreg = *(const v4u*)(vsrc + 32 * (kt)); } while (0)
#define DF_STORE(buf) do { *(LAS v4u*)(B.lds + ((buf) ? DF_K1 : DF_K0) + kdst) = kreg; const LAS unsigned char* vb_ = B.lds + ((buf) ? DF_V1 : DF_V0) + vdst; \
        *(LAS v2u*)vb_ = (v2u){vreg.x, vreg.y}; *(LAS v2u*)(vb_ + 8) = (v2u){vreg.z, vreg.w}; } while (0)
    DF_LOAD(0); DF_STORE(0);
    __syncthreads();
    for (int kt = 0; kt < NKEY / 32; ++kt) {
        if (kt + 1 < NKEY / 32) DF_LOAD(kt + 1);
        const LAS bf16* Ks = (const LAS bf16*)(B.lds + ((kt & 1) ? DF_K1 : DF_K0)); const LAS bf16* Vs = (const LAS bf16*)(B.lds + ((kt & 1) ? DF_V1 : DF_V0));
        f32x16 s; float al0, al1; bf16x8 pa0, pa1, pb0, pb1; bool rs0, rs1;
#pragma unroll
        for (int e = 0; e < 16; ++e) s[e] = 0.f;
#pragma unroll
        for (int ks = 0; ks < 4; ++ks) { const bf16x8 kf = *(const LAS bf16x8*)(Ks + r32 * DK_P + 16 * ks + 8 * hh), qf = *(const LAS bf16x8*)(Qs + r32 * DK_P + 16 * ks + 8 * hh); s = MFMA32(kf, qf, s); }
        sm_update(s, m0, l0, al0, pa0, pa1, rs0);
#pragma unroll
        for (int e = 0; e < 16; ++e) s[e] = 0.f;
#pragma unroll
        for (int ks = 0; ks < 4; ++ks) { const bf16x8 kf = *(const LAS bf16x8*)(Ks + r32 * DK_P + 64 + 16 * ks + 8 * hh), qf = *(const LAS bf16x8*)(Qs + r32 * DK_P + 64 + 16 * ks + 8 * hh); s = MFMA32(kf, qf, s); }
        sm_update(s, m1, l1, al1, pb0, pb1, rs1);
        if (rs0) {
#pragma unroll
            for (int d = 0; d < 4; ++d)
#pragma unroll
                for (int e = 0; e < 16; ++e) Oa[d][e] *= al0; }
        if (rs1) {
#pragma unroll
            for (int d = 0; d < 4; ++d)
#pragma unroll
                for (int e = 0; e < 16; ++e) Ob[d][e] *= al1; }
#pragma unroll
        for (int d = 0; d < 4; ++d) {
            const LAS bf16* vr = Vs + (32 * d + r32) * DV_P + 4 * hh;
            const v2u a0 = *(const LAS v2u*)(vr), a1 = *(const LAS v2u*)(vr + 8), a2 = *(const LAS v2u*)(vr + 16), a3 = *(const LAS v2u*)(vr + 24);
            const bf16x8 v0 = __builtin_bit_cast(bf16x8, ((v4u){a0.x, a0.y, a1.x, a1.y})), v1 = __builtin_bit_cast(bf16x8, ((v4u){a2.x, a2.y, a3.x, a3.y}));
            Oa[d] = MFMA32(v0, pa0, Oa[d]); Oa[d] = MFMA32(v1, pa1, Oa[d]); Ob[d] = MFMA32(v0, pb0, Ob[d]); Ob[d] = MFMA32(v1, pb1, Ob[d]); }
        if (kt + 1 < NKEY / 32) DF_STORE((kt + 1) & 1);
        __syncthreads();
    }
#undef DF_LOAD
#undef DF_STORE
    const float i0 = 1.0f / xhalf_sum(l0), i1 = (DBG_DIFF_LAM0 ? 0.f : lam) / xhalf_sum(l1); float ss = 0.f;
#pragma unroll
    for (int d = 0; d < 4; ++d)
#pragma unroll
        for (int e = 0; e < 16; ++e) { const float o = Oa[d][e] * i0 - Ob[d][e] * i1; Oa[d][e] = o; ss += o * o; }
    const float rms = (DBG_Z_DIFF || DBG_HZ_DIFF(hd)) ? 0.f : DBG_S_DIFF / sqrtf(xhalf_sum(ss) * (1.0f / 128.0f) + RMS_EPS) * (1.0f - LAMBDA_INIT);
    bf16* yo = YM + qrow * D + 512 + hd * 128 + 4 * hh; const float* ng = a.in[I_DNG] + 4 * hh;
#pragma unroll
    for (int d = 0; d < 4; ++d)
#pragma unroll
        for (int eg = 0; eg < 4; ++eg) { const f32x4 g = *(const f32x4*)(ng + 32 * d + 8 * eg);
            v2u o; o.x = pk2(Oa[d][4 * eg] * rms * g[0], Oa[d][4 * eg + 1] * rms * g[1]); o.y = pk2(Oa[d][4 * eg + 2] * rms * g[2], Oa[d][4 * eg + 3] * rms * g[3]); *(v2u*)(yo + 32 * d + 8 * eg) = o; }
}

constexpr int GP = 72;
constexpr int GL_G = 0, GL_BL = 16384, GL_BR = 16640, GL_QD = 16896, GL_KD = GL_QD + 64 * GP * 2, GL_QS = GL_KD + 64 * GP * 2, GL_KE = GL_QS + 64 * GP * 2, GL_AM = GL_KE + 64 * GP * 2, GL_VT = GL_AM + 64 * GP * 2, GL_ST = GL_VT + 128 * GP * 2, GL_END = GL_ST + 128 * GP * 2;
__device__ __forceinline__ float logsig(float x) { return fminf(x, 0.f) - log1pf(__expf(-fabsf(x))); }
__device__ __forceinline__ void gla_scan(const Args& a, const Blk& B, int scan) {
    const bf16* U1 = (const bf16*)(a.ws + WS_R2); bf16* YM = (bf16*)(a.ws + WS_H); bf16* GOB = (bf16*)(a.ws + WS_GOB);
    const int dir = scan & 1, h = (scan >> 1) & 3, b = scan >> 3, lane = B.lane, r32 = lane & 31, hh = lane >> 5, w = B.wave;
    LAS float* G = (LAS float*)(B.lds + GL_G); LAS float* BL = (LAS float*)(B.lds + GL_BL); LAS float* BR = (LAS float*)(B.lds + GL_BR);
    LAS bf16* QD = (LAS bf16*)(B.lds + GL_QD); LAS bf16* KD = (LAS bf16*)(B.lds + GL_KD); LAS bf16* QS = (LAS bf16*)(B.lds + GL_QS); LAS bf16* KE = (LAS bf16*)(B.lds + GL_KE);
    LAS bf16* AM = (LAS bf16*)(B.lds + GL_AM); LAS bf16* VTL = (LAS bf16*)(B.lds + GL_VT); LAS bf16* STL = (LAS bf16*)(B.lds + GL_ST);
    float g2c[16];
#pragma unroll
    for (int j = 0; j < 16; ++j) g2c[j] = a.in[I_GLAG2][(size_t)(dir * 16 + j) * 256 + h * 64 + lane];
    const float gbv = a.in[I_GLAGB][dir * 256 + h * 64 + lane];
    f32x16 Sacc;
#pragma unroll
    for (int e = 0; e < 16; ++e) Sacc[e] = 0.f;
    for (int i = B.tid; i < 128 * GP / 2; i += 512) ((LAS unsigned*)STL)[i] = 0u;
    __syncthreads();
    for (int cc = 0; cc < 36; ++cc) {
        const bool isctx = cc < 4; const int ci = isctx ? (dir ? 3 - cc : cc) : (dir ? 35 - cc : cc - 4);
        const size_t row0 = isctx ? (size_t)M_LAT + b * CTXL + ci * 64 : (size_t)b * SEQ + ci * 64;
#if DBG_CHECKS
        if (scan == 18 && cc == 4) { float* dq = (float*)(a.ws + WS_CTL) + 65536; for (int i = B.tid; i < 8192; i += 512) dq[4096 + i] = bf2f(STL[(i >> 6) * GP + (i & 63)]); }
#endif
#pragma unroll
        for (int q = 0; q < 8; ++q) { const int tau = 8 * w + q; const bf16* gp = U1 + (row0 + tau) * U1_LD + 1536 + 16 * dir; const v4u g0 = *(const v4u*)gp, g1 = *(const v4u*)(gp + 8);
            const unsigned gw[8] = {g0.x, g0.y, g0.z, g0.w, g1.x, g1.y, g1.z, g1.w}; float s = gbv;
#pragma unroll
            for (int j = 0; j < 8; ++j) s += DBG_GLA_NOGD ? 0.f : (bflo(gw[j]) * g2c[2 * j] + bfhi(gw[j]) * g2c[2 * j + 1]);
            G[tau * 64 + lane] = logsig(s) * (1.0f / 16.0f); }
        __syncthreads();
        if (w == 0) { float acc = 0.f;
            if (!dir) { for (int tau = 0; tau < 64; ++tau) { acc += G[tau * 64 + lane]; G[tau * 64 + lane] = acc; if (tau == 31) BR[lane] = acc; } }
            else { for (int tau = 63; tau >= 0; --tau) { acc += G[tau * 64 + lane]; G[tau * 64 + lane] = acc; if (tau == 32) BR[lane] = acc; } }
            BL[lane] = acc; }
        __syncthreads();
        { const int tau = B.tid >> 3, k0 = (B.tid & 7) * 8; const bf16* ur = U1 + (row0 + tau) * U1_LD;
          const v4u qv = *(const v4u*)(ur + h * 64 + k0), kv = *(const v4u*)(ur + 256 + h * 64 + k0);
          const unsigned qw[4] = {qv.x, qv.y, qv.z, qv.w}, kw[4] = {kv.x, kv.y, kv.z, kv.w};
          float qd[8], kd[8], qs[8], ke[8];
#pragma unroll
          for (int e = 0; e < 8; ++e) { const float bc = G[tau * 64 + k0 + e], br = BR[k0 + e], bl = BL[k0 + e];
              const float qq = (e & 1) ? bfhi(qw[e >> 1]) : bflo(qw[e >> 1]), kk = (e & 1) ? bfhi(kw[e >> 1]) : bflo(kw[e >> 1]);
              qd[e] = qq * __expf(bc - br); kd[e] = kk * __expf(br - bc); qs[e] = qq * __expf(bc); ke[e] = kk * __expf(bl - bc); }
          v4u o; o.x = pk2s(qd[0], qd[1]); o.y = pk2s(qd[2], qd[3]); o.z = pk2s(qd[4], qd[5]); o.w = pk2s(qd[6], qd[7]); *(LAS v4u*)(QD + tau * GP + k0) = o;
          o.x = pk2s(kd[0], kd[1]); o.y = pk2s(kd[2], kd[3]); o.z = pk2s(kd[4], kd[5]); o.w = pk2s(kd[6], kd[7]); *(LAS v4u*)(KD + tau * GP + k0) = o;
          o.x = pk2s(qs[0], qs[1]); o.y = pk2s(qs[2], qs[3]); o.z = pk2s(qs[4], qs[5]); o.w = pk2s(qs[6], qs[7]); *(LAS v4u*)(QS + tau * GP + k0) = o;
#pragma unroll
          for (int e = 0; e < 8; ++e) KE[(k0 + e) * GP + tau] = f2bfs(ke[e]);
          const int d0 = (B.tid & 7) * 16; const v4u va = *(const v4u*)(ur + 512 + h * 128 + d0), vb = *(const v4u*)(ur + 512 + h * 128 + d0 + 8);
          const unsigned vw[8] = {va.x, va.y, va.z, va.w, vb.x, vb.y, vb.z, vb.w};
#pragma unroll
          for (int e = 0; e < 8; ++e) { VTL[(d0 + 2 * e) * GP + tau] = (bf16)(vw[e] & 0xffffu); VTL[(d0 + 2 * e + 1) * GP + tau] = (bf16)(vw[e] >> 16); } }
        __syncthreads();
        f32x16 Oacc;
        const int dvt = w >> 1, tt = w & 1;
        if (!isctx) {
#pragma unroll
            for (int e = 0; e < 16; ++e) Oacc[e] = 0.f;
#pragma unroll
            for (int ks = 0; ks < 4; ++ks) { const bf16x8 af = *(const LAS bf16x8*)(STL + (32 * dvt + r32) * GP + 16 * ks + 8 * hh), bfr = *(const LAS bf16x8*)(QS + (32 * tt + r32) * GP + 16 * ks + 8 * hh); Oacc = MFMA32(af, bfr, Oacc); }
#if DBG_CHECKS
            if (scan == 18 && cc == 4) { float* dq = (float*)(a.ws + WS_CTL) + 65536; for (int i = B.tid; i < 4096; i += 512) dq[i] = bf2f(QS[(i >> 6) * GP + (i & 63)]); }
            if (scan == 18 && cc == 4) { float* dbg = (float*)(a.ws + WS_CTL) + 32768; for (int e = 0; e < 16; ++e) dbg[(32 * tt + r32) * 128 + 32 * dvt + (e & 3) + 8 * (e >> 2) + 4 * hh] = Oacc[e]; }
#endif
            if (w < 4) { const int st = w & 1, t2 = w >> 1; f32x16 am;
#pragma unroll
                for (int e = 0; e < 16; ++e) am[e] = 0.f;
#pragma unroll
                for (int ks = 0; ks < 4; ++ks) { const bf16x8 af = *(const LAS bf16x8*)(KD + (32 * st + r32) * GP + 16 * ks + 8 * hh), bfr = *(const LAS bf16x8*)(QD + (32 * t2 + r32) * GP + 16 * ks + 8 * hh); am = MFMA32(af, bfr, am); }
                const int t = 32 * t2 + r32;
#pragma unroll
                for (int eg = 0; eg < 4; ++eg) { float o[4];
#pragma unroll
                    for (int e = 0; e < 4; ++e) { const int s = 32 * st + 8 * eg + 4 * hh + e; const bool ok = dir ? (s >= t) : (s <= t); o[e] = ok ? am[4 * eg + e] : 0.f; }
                    v2u pw; pw.x = pk2s(o[0], o[1]); pw.y = pk2s(o[2], o[3]); *(LAS v2u*)(AM + t * GP + 32 * st + 8 * eg + 4 * hh) = pw; } }
        }
        __syncthreads();
        if (!isctx) {
#pragma unroll
            for (int ks = 0; ks < 4; ++ks) { const bf16x8 af = *(const LAS bf16x8*)(VTL + (32 * dvt + r32) * GP + 16 * ks + 8 * hh), bfr = *(const LAS bf16x8*)(AM + (32 * tt + r32) * GP + 16 * ks + 8 * hh); Oacc = MFMA32(af, bfr, Oacc); }
#if DBG_CHECKS
            if (scan == 18 && cc == 4) { float* dbg = (float*)(a.ws + WS_CTL) + 32768 + 8192; for (int e = 0; e < 16; ++e) dbg[(32 * tt + r32) * 128 + 32 * dvt + (e & 3) + 8 * (e >> 2) + 4 * hh] = Oacc[e]; }
#endif
            bf16* orow = (dir ? GOB + (row0 + 32 * tt + r32) * 512 : YM + (row0 + 32 * tt + r32) * D) + h * 128 + 32 * dvt + 4 * hh;
#pragma unroll
            for (int eg = 0; eg < 4; ++eg) { v2u o; o.x = pk2s(Oacc[4 * eg], Oacc[4 * eg + 1]); o.y = pk2s(Oacc[4 * eg + 2], Oacc[4 * eg + 3]); *(v2u*)(orow + 8 * eg) = o; }
        }
        { const int kt = w & 1; const float dec = __expf(BL[32 * kt + r32]);
#pragma unroll
          for (int e = 0; e < 16; ++e) Sacc[e] *= dec;
#pragma unroll
          for (int ks = 0; ks < 4; ++ks) { const bf16x8 af = *(const LAS bf16x8*)(VTL + (32 * dvt + r32) * GP + 16 * ks + 8 * hh), bfr = *(const LAS bf16x8*)(KE + (32 * kt + r32) * GP + 16 * ks + 8 * hh); Sacc = MFMA32(af, bfr, Sacc); }
        }
        { const int kt = w & 1;
#pragma unroll
          for (int e = 0; e < 16; ++e) STL[(32 * dvt + (e & 3) + 8 * (e >> 2) + 4 * hh) * GP + 32 * kt + r32] = f2bfs(Sacc[e]);
#if DBG_CHECKS
          if (scan == 18 && cc == 3) { float* dbg = (float*)(a.ws + WS_CTL) + 24576; for (int e = 0; e < 16; ++e) dbg[(32 * dvt + (e & 3) + 8 * (e >> 2) + 4 * hh) * 64 + 32 * kt + r32] = Sacc[e]; }
#endif
          }
        __syncthreads();
    }
}
__device__ __forceinline__ void gla_post_phase(const Args& a, const Blk& B) {
    const bf16* U1 = (const bf16*)(a.ws + WS_R2); bf16* YM = (bf16*)(a.ws + WS_H); const bf16* GOB = (const bf16*)(a.ws + WS_GOB);
    const int gw = B.bid * NWAVES + B.wave, NGW = B.G * NWAVES, c0 = 8 * B.lane;
    const f32x4 n0 = *(const f32x4*)(a.in[I_GLANG] + (c0 & 127)), n1 = *(const f32x4*)(a.in[I_GLANG] + (c0 & 127) + 4);
    for (int row = gw; row < M_LAT; row += NGW) {
        const v4u of = *(const v4u*)(YM + (size_t)row * D + c0), ob = *(const v4u*)(GOB + (size_t)row * 512 + c0), rv = *(const v4u*)(U1 + (size_t)row * U1_LD + 1024 + c0);
        const unsigned fw[4] = {of.x, of.y, of.z, of.w}, bw[4] = {ob.x, ob.y, ob.z, ob.w}, rw[4] = {rv.x, rv.y, rv.z, rv.w};
        float o[8], ss = 0.f;
#pragma unroll
        for (int e = 0; e < 4; ++e) { { const float cf = DBG_GLA_NOF ? 0.f : 1.f, cb = DBG_GLA_NOB ? 0.f : 1.f; o[2 * e] = cf * bflo(fw[e]) + cb * bflo(bw[e]); o[2 * e + 1] = cf * bfhi(fw[e]) + cb * bfhi(bw[e]); } ss += o[2 * e] * o[2 * e] + o[2 * e + 1] * o[2 * e + 1]; }
        const float rms = (DBG_Z_GLA || DBG_HZ_GLA(B.lane >> 4)) ? 0.f : DBG_S_GLA / sqrtf(row16_sum(ss) * (1.0f / 128.0f) + RMS_EPS);
        float y[8];
#pragma unroll
        for (int e = 0; e < 8; ++e) { const float r = (e & 1) ? bfhi(rw[e >> 1]) : bflo(rw[e >> 1]); const float ng = e < 4 ? n0[e] : n1[e - 4]; y[e] = o[e] * rms * ng * (r * sigmoid_f(r)); }
        v4u w; w.x = pk2(y[0], y[1]); w.y = pk2(y[2], y[3]); w.z = pk2(y[4], y[5]); w.w = pk2(y[6], y[7]); *(v4u*)(YM + (size_t)row * D + c0) = w;
    }
}

#ifndef DBG_CHECKS
#define DBG_CHECKS 0
#endif
#ifndef DBG_MSHIFT
#define DBG_MSHIFT 0
#endif
#ifndef DBG_QSCHK
#define DBG_QSCHK 0
#endif
#ifndef DBG_GLADIR
#define DBG_GLADIR 0
#endif
#if DBG_CHECKS
constexpr int CW_CHK = 20480;
constexpr int CW_SAVE = 24576;
__device__ __forceinline__ void chk_fail(unsigned* ctl, unsigned code) { unsigned e = 0u; __hip_atomic_compare_exchange_strong(ctl + CW_CHK, &e, code, __ATOMIC_RELAXED, __ATOMIC_RELAXED, __HIP_MEMORY_SCOPE_AGENT); }
__device__ __forceinline__ bool chk_close(float got, float ref, float scale) { return fabsf(got - ref) <= 0.02f * scale + 0.003f; }
__device__ __forceinline__ float wmax(float v) { for (int o = 1; o < 64; o <<= 1) v = fmaxf(v, __shfl_xor(v, o)); return v; }
__device__ __forceinline__ float wsum(float v) { for (int o = 1; o < 64; o <<= 1) v += __shfl_xor(v, o); return v; }
__device__ __forceinline__ bool wany(bool b) { return __ballot(b) != 0ull; }

__device__ __forceinline__ void chk_na(const Args& a, unsigned* ctl, int lane) {
    const bf16* UB = (const bf16*)(a.ws + WS_R3); const bf16* YM = (const bf16*)(a.ws + WS_H); const float* rpb = a.in[I_RPB];
    const int smp[6][4] = {{0, 0, 0, 0}, {3, 5, 17, 40}, {15, 7, 31, 63}, {7, 2, 4, 31}, {9, 1, 27, 8}, {2, 3, -1, 100}};
#pragma unroll
    for (int si = 0; si < 6; ++si) { const int b = smp[si][0], h = smp[si][1], r = smp[si][2], c = smp[si][3]; const bool lat = r >= 0;
        const size_t qrow = lat ? (size_t)b * SEQ + r * 64 + c : (size_t)M_LAT + b * CTXL + c;
        float m = -1e30f;
        for (int pass = 0; pass < 2; ++pass) { float l = 0.f, o = 0.f;
            for (int j = 0; j < CTXL + (lat ? 128 : 0); ++j) { size_t krow; float bias = 0.f;
                if (j < CTXL) krow = (size_t)M_LAT + b * CTXL + j;
                else { const int jj = j - CTXL, i = jj >> 4, kc0 = jj & 15, rs = min(max(r - 4, 0), 24), cs = min(max(c - 8, 0), 48), kr = rs + i, kc = cs + kc0; krow = (size_t)b * SEQ + kr * 64 + kc; bias = rpb[(h * 15 + (kr - r + 7)) * 31 + (kc - c + 15)]; }
                float s = 0.f; for (int d = 0; d < 64; ++d) s += bf2f(UB[qrow * UB_LD + h * 64 + d]) * bf2f(UB[krow * UB_LD + 512 + h * 64 + d]);
                s += bias;
                if (pass == 0) m = fmaxf(m, s); else { const float p = expf(s - m); l += p; o += p * bf2f(UB[krow * UB_LD + 1024 + h * 64 + lane]); } }
            if (pass == 1) { const float ref = o / l, got = bf2f(YM[qrow * D + 512 + h * 64 + lane]); const float sc = wmax(fabsf(ref));
                if (wany(!chk_close(got, ref, sc))) { chk_fail(ctl, 7); return; } } }
    }
}
__device__ __forceinline__ void chk_rwkv_scan(const Args& a, unsigned* ctl, int lane, int b, int h, int dir, LAS float* sh) {
    const bf16* UA = (const bf16*)(a.ws + WS_R2); const float* Y = (const float*)(a.ws + WS_Y); const float* mu = a.in[I_MU];
    const int hc = h * 64 + lane; float S[64];
    _Pragma("unroll") for (int k = 0; k < 64; ++k) S[k] = 0.f;
    bool bad = false;
    for (int st = 0; st < CTXL + SEQ; ++st) { const bool isctx = st < CTXL; const int T = isctx ? CTXL : SEQ; const int tt = isctx ? st : st - CTXL, t = dir ? T - 1 - tt : tt;
        const size_t row = isctx ? (size_t)M_LAT + b * CTXL + t : (size_t)b * SEQ + t; const bool hp = t > 0, hn = t < T - 1;
        auto shf = [&](int col) { const float x0 = bf2f(UA[row * UA_LD + col]), xp = hp ? bf2f(UA[(row - 1) * UA_LD + col]) : 0.f, xn = hn ? bf2f(UA[(row + 1) * UA_LD + col]) : 0.f; return x0 + mu[col] * (0.5f * (xp + xn) - x0); };
        const float r_ = shf(hc), k_ = shf(512 + hc), v_ = shf(1024 + hc);
        float lw = 0.f, la = 0.f;
        for (int j = 0; j < 64; ++j) { lw += tanhf(shf(1536 + 64 * dir + j)) * a.in[I_W2][((size_t)dir * 64 + j) * 512 + hc]; la += shf(1664 + 64 * dir + j) * a.in[I_A2][((size_t)dir * 64 + j) * 512 + hc]; }
        const float wl = a.in[I_W0][dir * 512 + hc] + lw, w = expf(-expf(-log1pf(expf(-wl)) - 0.5f)), aa = 1.f / (1.f + expf(-(a.in[I_A0][dir * 512 + hc] + la)));
        const float kkr = k_ * a.in[I_KK][hc], kk = kkr / fmaxf(sqrtf(wsum(kkr * kkr)), 1e-12f), kt = k_ * (1.f + (aa - 1.f) * a.in[I_KA][hc]);
        sh[lane] = kk; sh[64 + lane] = w; sh[128 + lane] = kk * aa; sh[192 + lane] = kt; sh[256 + lane] = r_; __syncthreads();
        float sk = 0.f; _Pragma("unroll") for (int k = 0; k < 64; ++k) sk += S[k] * sh[k];
        float y = 0.f; _Pragma("unroll") for (int k = 0; k < 64; ++k) { S[k] = S[k] * sh[64 + k] - sk * sh[128 + k] + v_ * sh[192 + k]; y += S[k] * sh[256 + k]; }
        __syncthreads();
        if ((st & 127) == 5 || st == CTXL - 1 || st == CTXL || st == CTXL + SEQ - 1) { const float got = Y[((size_t)dir * M_ALL + row) * 512 + hc]; const float sc = wmax(fabsf(y)); if (wany(!chk_close(got, y, sc))) bad = true; }
    }
    if (bad) chk_fail(ctl, 8);
}
__device__ __forceinline__ void chk_rwkv_post(const Args& a, unsigned* ctl, int lane) {
    const bf16* UA = (const bf16*)(a.ws + WS_R2); const float* Y = (const float*)(a.ws + WS_Y); const bf16* YM = (const bf16*)(a.ws + WS_H); const float* mu = a.in[I_MU];
    const size_t rows[5] = {0, 2047, 12345, (size_t)M_LAT + 7, (size_t)M_ALL - 1};
#pragma unroll
    for (int si = 0; si < 5; ++si) { const size_t row = rows[si]; const bool isctx = row >= (size_t)M_LAT; const int T = isctx ? CTXL : SEQ, t = isctx ? (int)((row - M_LAT) % CTXL) : (int)(row % SEQ); const bool hp = t > 0, hn = t < T - 1;
        auto shf = [&](int col) { const float x0 = bf2f(UA[row * UA_LD + col]), xp = hp ? bf2f(UA[(row - 1) * UA_LD + col]) : 0.f, xn = hn ? bf2f(UA[(row + 1) * UA_LD + col]) : 0.f; return x0 + mu[col] * (0.5f * (xp + xn) - x0); };
        for (int hd = 0; hd < 8; hd += 3) { const int ch = hd * 64 + lane; const float y = Y[row * 512 + ch] + Y[((size_t)M_ALL + row) * 512 + ch];
            const float mean = wsum(y) / 64.f, var = wsum((y - mean) * (y - mean)) / 64.f; const float rk = wsum(shf(ch) * shf(512 + ch) * a.in[I_RK][ch]);
            float g = 0.f; for (int j = 0; j < 128; ++j) g += (1.f / (1.f + expf(-shf(1792 + j)))) * a.in[I_G2][(size_t)j * 512 + ch];
            const float ref = ((y - mean) / sqrtf(var + GN_EPS) * a.in[I_GNG][ch] + a.in[I_GNB][ch] + rk * shf(1024 + ch)) * g, got = bf2f(YM[row * D + ch]); const float sc = wmax(fabsf(ref));
            if (wany(!chk_close(got, ref, sc))) { chk_fail(ctl, 9); return; } } }
}
__device__ __forceinline__ void chk_diff(const Args& a, unsigned* ctl, int lane) {
    const bf16* U1 = (const bf16*)(a.ws + WS_R2); const bf16* YM = (const bf16*)(a.ws + WS_H);
    const float* lp = a.in[I_DLAM]; const float lam = expf(wsum(lp[lane] * lp[64 + lane])) - expf(wsum(lp[128 + lane] * lp[192 + lane])) + LAMBDA_INIT;
    const int smp[4][3] = {{0, 0, 0}, {5, 2, 1234}, {15, 3, 2047}, {8, 1, 64}};
#pragma unroll
    for (int si = 0; si < 4; ++si) { const int b = smp[si][0], hd = smp[si][1], t = smp[si][2]; const size_t qrow = (size_t)b * SEQ + t; float o0[2] = {0.f, 0.f}, o1[2] = {0.f, 0.f};
        for (int mm = 0; mm < 2; ++mm) { float m = -1e30f, l = 0.f, oa = 0.f, ob = 0.f;
            for (int pass = 0; pass < 2; ++pass)
                for (int j = 0; j < NKEY; ++j) { const size_t krow = j < SEQ ? (size_t)b * SEQ + j : (size_t)M_LAT + b * CTXL + (j - SEQ);
                    float s = 0.f; for (int d = 0; d < 64; ++d) s += bf2f(U1[qrow * U1_LD + 1568 + hd * 128 + mm * 64 + d]) * bf2f(U1[krow * U1_LD + 2080 + hd * 128 + mm * 64 + d]);
                    if (pass == 0) m = fmaxf(m, s); else { const float p = expf(s - m); l += p; oa += p * bf2f(U1[krow * U1_LD + 2592 + hd * 128 + lane]); ob += p * bf2f(U1[krow * U1_LD + 2592 + hd * 128 + 64 + lane]); } }
            if (mm == 0) { o0[0] = oa / l; o0[1] = ob / l; } else { o1[0] = oa / l; o1[1] = ob / l; } }
        const float oa = o0[0] - lam * o1[0], ob = o0[1] - lam * o1[1]; const float rms = 1.f / sqrtf(wsum(oa * oa + ob * ob) / 128.f + RMS_EPS) * (1.f - LAMBDA_INIT);
        const float ra = oa * rms * a.in[I_DNG][lane], rb = ob * rms * a.in[I_DNG][64 + lane]; const float sc = wmax(fmaxf(fabsf(ra), fabsf(rb)));
        const float ga = bf2f(YM[qrow * D + 512 + hd * 128 + lane]), gb = bf2f(YM[qrow * D + 512 + hd * 128 + 64 + lane]);
        if (wany(!chk_close(ga, ra, sc) || !chk_close(gb, rb, sc))) { chk_fail(ctl, 13); return; } }
}
__device__ __forceinline__ void chk_gla(const Args& a, unsigned* ctl, int lane, int b, int h, int dir, LAS float* sh) {
    const bf16* U1 = (const bf16*)(a.ws + WS_R2); const bf16* YM = (const bf16*)(a.ws + WS_H); const bf16* GOB = (const bf16*)(a.ws + WS_GOB);
    float Sa[64], Sb[64]; _Pragma("unroll") for (int k = 0; k < 64; ++k) { Sa[k] = 0.f; Sb[k] = 0.f; }
    float S0[64]; _Pragma("unroll") for (int k = 0; k < 64; ++k) S0[k] = 0.f; float cum = 0.f, mrI = 0.f, msI = 0.f, mrT = 0.f, msT = 0.f;
    bool bad = false; float maxrel = 0.f; int nsmp = 0, firstbad = -1; unsigned bmask = 0u; float minrel = 1e9f;
    for (int st = 0; st < CTXL + SEQ; ++st) { const bool isctx = st < CTXL; const int T = isctx ? CTXL : SEQ; const int tt = isctx ? st : st - CTXL, t = dir ? T - 1 - tt : tt;
        const size_t row = isctx ? (size_t)M_LAT + b * CTXL + t : (size_t)b * SEQ + t; const bf16* ur = U1 + row * U1_LD;
        float s = a.in[I_GLAGB][dir * 256 + h * 64 + lane]; for (int j = 0; j < 16; ++j) s += bf2f(ur[1536 + 16 * dir + j]) * a.in[I_GLAG2][(size_t)(dir * 16 + j) * 256 + h * 64 + lane];
        const float g = (fminf(s, 0.f) - log1pf(expf(-fabsf(s)))) / 16.f;
        sh[lane] = expf(g); sh[64 + lane] = bf2f(ur[256 + h * 64 + lane]); sh[128 + lane] = bf2f(ur[h * 64 + lane]); __syncthreads();
        const float va = bf2f(ur[512 + h * 128 + lane]), vb = bf2f(ur[512 + h * 128 + 64 + lane]); float oa = 0.f, ob = 0.f;
        _Pragma("unroll") for (int k = 0; k < 64; ++k) { Sa[k] = sh[k] * Sa[k] + sh[64 + k] * va; Sb[k] = sh[k] * Sb[k] + sh[64 + k] * vb; oa += sh[128 + k] * Sa[k]; ob += sh[128 + k] * Sb[k]; }
        __syncthreads();
        if (st == CTXL - 1) { _Pragma("unroll") for (int k = 0; k < 64; ++k) S0[k] = Sa[k]; }
        if (st == CTXL - 1 && DBG_MSHIFT == 4) { const float* dq = (const float*)(a.ws + WS_CTL) + 65536 + 4096; float ms = 0.f; int nb = 0;
            _Pragma("unroll") for (int k = 0; k < 64; ++k) ms = fmaxf(ms, fabsf(Sa[k]));
            ms = wmax(ms);
            _Pragma("unroll") for (int k = 0; k < 64; ++k) { if (fabsf(dq[lane * 64 + k] - Sa[k]) > 0.05f * fabsf(Sa[k]) + 1e-3f * ms) ++nb; }
            nb = (int)wsum((float)nb); int c = nb * 60 / 4096; if (nb && !c) c = 1; chk_fail(ctl, 16 + c); return; }
        if (!isctx && st < CTXL + 64 && (DBG_MSHIFT == 2 || DBG_MSHIFT == 3)) { cum += g; sh[320 + lane] = expf(cum); __syncthreads(); float oi = 0.f; _Pragma("unroll") for (int k = 0; k < 64; ++k) oi += sh[128 + k] * sh[320 + k] * S0[k]; __syncthreads();
            const float* dbg = (const float*)(a.ws + WS_CTL) + 32768; const float gi = dbg[(st - CTXL) * 128 + lane], gt = dbg[8192 + (st - CTXL) * 128 + lane];
            if (DBG_MSHIFT == 2 && DBG_QSCHK) { const float* dq = (const float*)(a.ws + WS_CTL) + 65536; const float qref = sh[128 + lane] * sh[320 + lane]; mrI = fmaxf(mrI, fabsf(dq[(st - CTXL) * 64 + lane] - qref)); msI = fmaxf(msI, fabsf(qref)); } else {
            mrI = fmaxf(mrI, fabsf(gi - oi)); msI = fmaxf(msI, fabsf(oi)); } mrT = fmaxf(mrT, fabsf(gt - oa)); msT = fmaxf(msT, fabsf(oa));
            if (st == CTXL + 63) { mrI = wmax(mrI); msI = wmax(msI); mrT = wmax(mrT); msT = wmax(msT); int c = (int)((DBG_MSHIFT == 2 ? mrI / msI : mrT / msT) * 50.f); c = c > 60 ? 60 : c; chk_fail(ctl, 16 + c); return; } }
        if (st == CTXL - 1 && DBG_MSHIFT == 1) { const float* dbg = (const float*)(a.ws + WS_CTL) + 24576; float ms = 0.f; int nb = 0;
            _Pragma("unroll") for (int k = 0; k < 64; ++k) ms = fmaxf(ms, fmaxf(fabsf(Sa[k]), fabsf(Sb[k])));
            ms = wmax(ms);
            _Pragma("unroll") for (int k = 0; k < 64; ++k) { if (fabsf(dbg[lane * 64 + k] - Sa[k]) > 0.05f * fabsf(Sa[k]) + 1e-3f * ms) ++nb; if (fabsf(dbg[(64 + lane) * 64 + k] - Sb[k]) > 0.05f * fabsf(Sb[k]) + 1e-3f * ms) ++nb; }
            nb = (int)wsum((float)nb); int c = nb * 60 / 8192; if (nb && !c) c = 1; chk_fail(ctl, 16 + c); return; }
        if (!isctx && ((st & 255) == 3 || st == CTXL || st == CTXL + 63 || st == CTXL + 64 || st == CTXL + SEQ - 1)) { const bf16* op = dir ? GOB + row * 512 : YM + row * D;
            const float ga = bf2f(op[h * 128 + lane]), gb = bf2f(op[h * 128 + 64 + lane]); const float sc = wmax(fmaxf(fabsf(oa), fabsf(ob)));
            const float rel = wmax(fmaxf(fabsf(ga - oa), fabsf(gb - ob))) / (sc + 1e-6f); maxrel = fmaxf(maxrel, rel); minrel = fminf(minrel, rel); if (rel > 0.05f && firstbad < 0) firstbad = nsmp; if (rel > 0.05f) bmask |= 1u << nsmp; ++nsmp; }
    }
    { int c = (int)((DBG_MSHIFT ? maxrel : minrel) * 50.f); c = c > 60 ? 60 : c; chk_fail(ctl, 16 + c); }
}
__device__ __forceinline__ void chk_act(const Args& a, unsigned* ctl, int lane) {
    const bf16* H = (const bf16*)(a.ws + WS_H); const bf16* ACT = (const bf16*)(a.ws + WS_R2); const float* W = a.in[I_GU0];
    const size_t rows[3] = {0, 20000, (size_t)M_ALL - 1}; bool bad = false;
#pragma unroll
    for (int si = 0; si < 3; ++si) { const size_t row = rows[si]; const int j = (lane * 44 + si * 7) % FF; float g = 0.f, u = 0.f;
        for (int k = 0; k < D; ++k) { const float hv = bf2f(H[row * D + k]); g += hv * W[(size_t)k * NGU + j]; u += hv * W[(size_t)k * NGU + FF + j]; }
        const float ref = g / (1.f + expf(-g)) * u, got = bf2f(ACT[row * FF + j]); if (!chk_close(got, ref, fabsf(ref) + 0.2f)) bad = true; }
    if (wany(bad)) chk_fail(ctl, 3);
}
__device__ __forceinline__ void chk_z(const Args& a, unsigned* ctl, int lane) {
    const bf16* ACT = (const bf16*)(a.ws + WS_R2); const float* W = a.in[I_DN0]; const float* mod = modptr(a, 0);
    const size_t rows[3] = {5, 20000, (size_t)M_ALL - 2}; bool bad = false;
#pragma unroll
    for (int si = 0; si < 3; ++si) { const size_t row = rows[si]; const int col = (lane * 16 + si * 5) % D; float y = 0.f;
        for (int j = 0; j < FF; ++j) y += bf2f(ACT[row * FF + j]) * W[(size_t)j * D + col];
        const bool isctx = row >= (size_t)M_LAT; const int set = isctx ? 16 : (int)(row >> 11); const float x = isctx ? a.in[I_CTX][(row - M_LAT) * D + col] : a.in[I_X][row * D + col];
        const float ref = ALPHA * x + mod[(size_t)(set * 9 + 2) * D + col] * 0.5f * y, got = isctx ? ((const float*)(a.ws + WS_XSC))[(row - M_LAT) * D + col] : a.out[row * D + col];
        if (fabsf(got - ref) > 0.003f + 0.002f * fabsf(ref)) bad = true; }
    if (wany(bad)) chk_fail(ctl, 4);
}
__device__ __forceinline__ void chk_mod(const Args& a, unsigned* ctl, int lane) {
    bool bad = false;
#pragma unroll
    for (int si = 0; si < 4; ++si) { const int l = si & 1, set = si == 3 ? 16 : si * 5, n = (lane * 144 + si * 1000 + 7) % (NMOD * D); float s = a.in[I_BMOD0 + l * LSTRIDE][n];
        for (int k = 0; k < D; ++k) { const float c = set < 16 ? a.in[I_C][set * D + k] : a.in[I_CCTX][k]; s += c / (1.f + expf(-c)) * a.in[I_WMOD0 + l * LSTRIDE][(size_t)k * (NMOD * D) + n]; }
        if (fabsf(modptr(a, l)[(size_t)set * (NMOD * D) + n] - s) > 1e-3f) bad = true; }
    if (wany(bad)) chk_fail(ctl, 1);
}
__device__ __forceinline__ void chk_u0(const Args& a, unsigned* ctl, int lane) {
    const bf16* H = (const bf16*)(a.ws + WS_H); const float* W = a.in[I_WIN0]; const bf16* UA = (const bf16*)(a.ws + WS_R2); const bf16* UB = (const bf16*)(a.ws + WS_R3);
    const size_t rows[3] = {1, 17000, (size_t)M_ALL - 3}; bool bad = false;
#pragma unroll
    for (int si = 0; si < 3; ++si) { const size_t row = rows[si]; const int col = (lane * 54 + si * 11) % NIN0; float u = 0.f;
        for (int k = 0; k < D; ++k) u += bf2f(H[row * D + k]) * W[(size_t)k * NIN0 + col];
        if (col >= 1920 && col < 2432) u *= 0.125f;
        const float got = col < 1920 ? bf2f(UA[row * UA_LD + col]) : bf2f(UB[row * UB_LD + col - 1920]); if (!chk_close(got, u, fabsf(u) + 0.2f)) bad = true; }
    if (wany(bad)) chk_fail(ctl, 6);
}
__device__ __forceinline__ void chk_ln(const Args& a, unsigned* ctl, int lane, int lni, int ish, int isc) {
    const bf16* H = (const bf16*)(a.ws + WS_H); const float* mod = modptr(a, 0); bool bad = false;
    const size_t rows[3] = {3, 30000, (size_t)M_ALL - 5};
#pragma unroll
    for (int si = 0; si < 3; ++si) { const size_t row = rows[si]; const bool isctx = row >= (size_t)M_LAT; const int set = isctx ? 16 : (int)(row >> 11);
        const float* xr = isctx ? (const float*)(a.ws + WS_XSC) + (row - M_LAT) * D : a.out + row * D; float s = 0.f, s2 = 0.f;
        for (int j = 0; j < 16; ++j) { const int c = lane + 64 * j; const float x = xr[c], n = (x - a.in[I_LNB0][lni * D + c]) / a.in[I_LNG0][lni * D + c]; s += n; s2 += n * n;
            const float h = x * (1.f + mod[(size_t)(set * 9 + isc) * D + c]) + mod[(size_t)(set * 9 + ish) * D + c]; if (!chk_close(bf2f(H[row * D + c]), h, fabsf(h))) bad = true; }
        const float mean = wsum(s) / D, var = wsum(s2) / D - mean * mean; if (fabsf(mean) > 1e-3f || fabsf(var - 1.f) > 1e-3f) bad = true; }
    if (wany(bad)) chk_fail(ctl, 5);
}
__global__ void __launch_bounds__(64) chk_kernel(Args a, int id) {
    __shared__ float sh[512]; unsigned* ctl = (unsigned*)(a.ws + WS_CTL); const int lane = threadIdx.x; LAS float* shl = (LAS float*)sh;
    if (id == 1) chk_mod(a, ctl, lane);
    if (id == 3) chk_act(a, ctl, lane);
    if (id == 4) chk_z(a, ctl, lane);
    if (id == 5) chk_ln(a, ctl, lane, 0, 3, 4);
    if (id == 6) chk_u0(a, ctl, lane);
    if (id == 7) chk_na(a, ctl, lane);
    if (id == 8) { if (blockIdx.x == 0) chk_rwkv_scan(a, ctl, lane, 1, 2, 0, shl); else chk_rwkv_scan(a, ctl, lane, 14, 5, 1, shl); }
    if (id == 9) chk_rwkv_post(a, ctl, lane);
    if (id == 13) chk_diff(a, ctl, lane);
    if (id == 14) { if (blockIdx.x == 0) chk_gla(a, ctl, lane, 2, 1, DBG_GLADIR, shl); }
}
__global__ void chk_apply(Args a) { const unsigned code = ((const unsigned*)(a.ws + WS_CTL))[CW_CHK]; if (!code) return;
    for (size_t i = (size_t)blockIdx.x * blockDim.x + threadIdx.x; i < (size_t)M_LAT * D; i += (size_t)gridDim.x * blockDim.x) a.out[i] += 0.1f * (float)code; }
#endif

#ifndef MK_MULTI
#define MK_MULTI 0
#endif
constexpr int PH_PER_LAYER = 13, N_PHASES = 2 + 2 * PH_PER_LAYER;
#define IN(k) (lo <= (k) && (k) < hi)
#define PHMARK(k) asm volatile("; PHMARK " #k ::: "memory")
#if DBG_TIMING
#define TSTAMP(cls) do { if (B.bid == 0 && B.tid == 0) { const unsigned long long t_ = __builtin_amdgcn_s_memrealtime(); MISC[32 + (cls)] += (unsigned)(t_ - (((unsigned long long)MISC[31] << 32) | MISC[30])); MISC[30] = (unsigned)t_; MISC[31] = (unsigned)(t_ >> 32); } } while (0)
#else
#define TSTAMP(cls) do { } while (0)
#endif
#define SEAM(k) do { if (IN(k) && IN((k) + 1)) xcd_barrier(bar); else __syncthreads(); TSTAMP(((k) < 2) ? 9 + (k) : (((k) - 2) % PH_PER_LAYER == 10 ? 0 : ((k) - 2) % PH_PER_LAYER == 11 ? 1 : ((k) - 2) % PH_PER_LAYER == 9 ? 2 : ((k) - 2) % PH_PER_LAYER == 12 ? 2 : ((k) - 2) % PH_PER_LAYER)); } while (0)
template <int l> __device__ __forceinline__ void layer_body(const Args& a, const Blk& B, const XcdBarrier& bar, volatile LAS unsigned* MISC, unsigned* ctl, int lo, int hi) {
    float* xs_lat = a.out; float* xs_ctx = (float*)(a.ws + WS_XSC); bf16* H = (bf16*)(a.ws + WS_H); bf16* ACT = (bf16*)(a.ws + WS_R2);

        const int pb = 2 + PH_PER_LAYER * l, lofs = l * LSTRIDE; const float* modl = modptr(a, l);
        const float* lng = a.in[I_LNG0 + lofs]; const float* lnb = a.in[I_LNB0 + lofs];
        const int m_post = l == 0 ? M_ALL : M_LAT;
        if (IN(pb + 0)) PHMARK(pb + 0); if (IN(pb + 0)) { pg8::Gemm g{H, wptr(a, l, W_GU), M_ALL, NGU, D}; pg8::StaticOrder S; S.init(M_ALL, NGU, B.G, B.bid); pg8::EpiGU E{ACT, FF};
            pg8::gemm_phase<pg8::EpiGU, pg8::StaticOrder, true, true>(B.lds, g, S, E); }
#if REP_GEMM > 1
        if (IN(pb + 0)) { __syncthreads(); pg8::Gemm g{H, wptr(a, l, W_GU), M_ALL, NGU, D}; pg8::StaticOrder S; S.init(M_ALL, NGU, B.G, B.bid); pg8::EpiGU E{ACT, FF};
            pg8::gemm_phase<pg8::EpiGU, pg8::StaticOrder, true, true>(B.lds, g, S, E); }
#endif
        SEAM(pb + 0);
        if (IN(pb + 1)) PHMARK(pb + 1); if (IN(pb + 1)) { pg8::Gemm g{ACT, wptr(a, l, W_DN), M_ALL, D, FF}; pg8::StaticOrder S; S.init(M_ALL, D, B.G, B.bid);
            pg8::EpiRes E{l == 0 ? a.in[I_X] : xs_lat, l == 0 ? a.in[I_CTX] : xs_ctx, xs_lat, xs_ctx, modl, 2, 0.5f * DBG_S_FFN, ALPHA};
            pg8::gemm_phase<pg8::EpiRes, pg8::StaticOrder, true, true>(B.lds, g, S, E); }
#if REP_DN > 1
        if (l == 0 && IN(pb + 1)) { __syncthreads(); pg8::Gemm g{ACT, wptr(a, l, W_DN), M_ALL, D, FF}; pg8::StaticOrder S; S.init(M_ALL, D, B.G, B.bid);
            pg8::EpiRes E{a.in[I_X], a.in[I_CTX], xs_lat, xs_ctx, modl, 2, 0.5f * DBG_S_FFN, ALPHA};
            pg8::gemm_phase<pg8::EpiRes, pg8::StaticOrder, true, true>(B.lds, g, S, E); }
#endif
        SEAM(pb + 1);
        if (IN(pb + 2)) PHMARK(pb + 2); if (IN(pb + 2)) ln_phase(B, xs_lat, xs_ctx, M_ALL, lng, lnb, modl, 3, 4, H);
#if REP_LN > 1
        if (IN(pb + 2)) { __syncthreads(); ln_dummy(B, xs_lat, xs_ctx, M_ALL, lng, lnb, modl, 3, 4, (float*)(a.ws + WS_R2), (bf16*)(a.ws + WS_R3)); }
#endif
        SEAM(pb + 2);
        if (IN(pb + 3)) PHMARK(pb + 3); if (IN(pb + 3)) { pg8::Gemm g{H, wptr(a, l, W_IN), M_ALL, l == 0 ? NIN0P : NIN1P, D}; pg8::StaticOrder S; S.init(M_ALL, g.N, B.G, B.bid);
            pg8::EpiIn E; E.Oa = (bf16*)(a.ws + WS_R2); E.Ob = (bf16*)(a.ws + WS_R3);
            if (l == 0) { E.lda = UA_LD; E.split = 1920; E.ldb = UB_LD; E.nvalid = NIN0; E.s1lo = 1920; E.s1hi = 2432; E.s2lo = 0; E.s2hi = 0; }
            else { E.lda = U1_LD; E.split = NIN1; E.ldb = 0; E.nvalid = NIN1; E.s1lo = 0; E.s1hi = 256; E.s2lo = 1568; E.s2hi = 2080; }
            pg8::gemm_phase<pg8::EpiIn, pg8::StaticOrder, true, true>(B.lds, g, S, E); }
        SEAM(pb + 3);
        if (l == 0) {
            if (IN(pb + 4)) PHMARK(pb + 4); if (IN(pb + 4)) for (int rep = 0; rep < REP_VT; ++rep) { __syncthreads(); vt_build<64>(B, (const bf16*)(a.ws + WS_R3), UB_LD, 1024, 8, (bf16*)(a.ws + WS_VT0)); }
            SEAM(pb + 4);
            if (IN(pb + 5)) PHMARK(pb + 5); if (IN(pb + 5)) for (int rep = 0; rep < REP_NA; ++rep) { __syncthreads(); na_phase(a, B); }
            SEAM(pb + 5);
            if (IN(pb + 6)) PHMARK(pb + 6); if (IN(pb + 6)) for (int rep = 0; rep < REP_SCAN; ++rep) { __syncthreads(); rwkv_scan_phase(a, B); }
            SEAM(pb + 6);
            if (IN(pb + 7)) PHMARK(pb + 7); if (IN(pb + 7)) for (int rep = 0; rep < REP_POST; ++rep) { __syncthreads(); rwkv_post_phase(a, B); }
            SEAM(pb + 7);
        } else {
            if (IN(pb + 4)) PHMARK(pb + 4); if (IN(pb + 4)) { rope_phase(a, B); for (int rep = 0; rep < REP_VT; ++rep) { __syncthreads(); vt_build<128>(B, (const bf16*)(a.ws + WS_R2), U1_LD, 2592, 4, (bf16*)(a.ws + WS_VT1)); } }
            SEAM(pb + 4);
#define P5_BODY(GLA_) do { if (GLA_) for (int scan = B.bid; scan < 128; scan += B.G) gla_scan(a, B, scan); \
                const float* lp = a.in[I_DLAM]; const float lam = __expf(wave_sum(lp[B.lane] * lp[64 + B.lane])) - __expf(wave_sum(lp[128 + B.lane] * lp[192 + B.lane])) + LAMBDA_INIT; \
                for (;;) { __syncthreads(); if (B.tid == 0) MISC[16] = __hip_atomic_fetch_add(ctl + CW_Q, 1u, RLX_AGENT); __syncthreads(); \
                    const int u = (int)MISC[16]; if (u >= NB * 4 * 8) break; \
                    diff_block(a, B, u >> 5, (u >> 3) & 3, u & 7, lam); } } while (0)
            if (IN(pb + 5)) PHMARK(pb + 5); if (IN(pb + 5)) { P5_BODY(1);
#if REP_P5 > 1
                xcd_barrier(bar); if (B.bid == 0 && B.tid == 0) __hip_atomic_store(ctl + CW_Q, 0u, RLX_AGENT); xcd_barrier(bar); P5_BODY(REP_P5 == 3);
#endif
            }
#undef P5_BODY
            if (IN(pb + 5) && IN(pb + 7)) xcd_barrier(bar); else __syncthreads(); TSTAMP(5);
            if (IN(pb + 7)) PHMARK(pb + 7); if (IN(pb + 7)) gla_post_phase(a, B);
            SEAM(pb + 7);
        }
        if (IN(pb + 8)) PHMARK(pb + 8); if (IN(pb + 8)) { pg8::Gemm g{H, wptr(a, l, W_OUT), m_post, D, D}; pg8::StaticOrder S; S.init(m_post, D, B.G, B.bid);
            pg8::EpiRes E{xs_lat, xs_ctx, xs_lat, xs_ctx, modl, 5, 1.0f, ALPHA};
            pg8::gemm_phase<pg8::EpiRes, pg8::StaticOrder, true, true>(B.lds, g, S, E); }
        SEAM(pb + 8);
        if (IN(pb + 9)) PHMARK(pb + 9); if (IN(pb + 9)) ln_phase(B, xs_lat, xs_ctx, m_post, lng + D, lnb + D, modl, 6, 7, H);
        SEAM(pb + 9);
        if (IN(pb + 10)) PHMARK(pb + 10); if (IN(pb + 10)) { pg8::Gemm g{H, wptr(a, l, W_GU) + (size_t)NGU * D, m_post, NGU, D}; pg8::StaticOrder S; S.init(m_post, NGU, B.G, B.bid); pg8::EpiGU E{ACT, FF};
            pg8::gemm_phase<pg8::EpiGU, pg8::StaticOrder, true, true>(B.lds, g, S, E); }
        SEAM(pb + 10);
        if (IN(pb + 11)) PHMARK(pb + 11); if (IN(pb + 11)) { pg8::Gemm g{ACT, wptr(a, l, W_DN) + (size_t)D * FF, m_post, D, FF}; pg8::StaticOrder S; S.init(m_post, D, B.G, B.bid);
            pg8::EpiRes E{xs_lat, xs_ctx, xs_lat, xs_ctx, modl, 8, 0.5f * DBG_S_FFN, ALPHA};
            pg8::gemm_phase<pg8::EpiRes, pg8::StaticOrder, true, true>(B.lds, g, S, E); }
        SEAM(pb + 11);
        if (IN(pb + 12)) PHMARK(pb + 12); if (IN(pb + 12)) { if (l == 0) ln_phase(B, xs_lat, xs_ctx, M_ALL, lng + 2 * D, lnb + 2 * D, modptr(a, 1), 0, 1, H); else ln_phase(B, xs_lat, xs_ctx, M_LAT, lng + 2 * D, lnb + 2 * D, nullptr, 0, 0, H); }
        if (l == 0) SEAM(pb + 12);
    }
__global__ void __launch_bounds__(NWAVES * 64, 2) fwd_kernel(Args a) {
    extern __shared__ __attribute__((aligned(16))) unsigned char lds_raw[];
    Blk B; B.lds = (LAS unsigned char*)lds_raw; B.tid = threadIdx.x; B.lane = B.tid & 63; B.wave = __builtin_amdgcn_readfirstlane(B.tid >> 6); B.G = gridDim.x; B.bid = blockIdx.x;
    volatile LAS unsigned* MISC = (volatile LAS unsigned*)(B.lds + MISC_OFF);
    if (B.tid < 64) MISC[B.tid] = 0u;
    __syncthreads();
    unsigned* ctl = (unsigned*)(a.ws + WS_CTL);
    const int lo = a.ph_lo, hi = a.ph_hi;
    XcdBarrier bar; bar.bar = ctl + CW_BAR; bar.x = 0; bar.st = MISC + 8;
    if (hi - lo > 1) bar = xcd_barrier_post(ctl + CW_BAR, MISC + 8);

    if (IN(0)) PHMARK(0); if (IN(0)) { p0_prologue(a, B); }
#if REP_P0 > 1
    if (IN(0)) { __syncthreads(); p0_prologue(a, B); }
#endif
    SEAM(0);
    if (IN(1)) PHMARK(1); if (IN(1)) { for (int rep = 0; rep < REP_H0; ++rep) { __syncthreads(); p1_h0(a, B); } } SEAM(1);

#if DBG_TIMING
    if (B.bid == 0 && B.tid == 0) { const unsigned long long t_ = __builtin_amdgcn_s_memrealtime(); MISC[30] = (unsigned)t_; MISC[31] = (unsigned)(t_ >> 32); }
#endif
    layer_body<0>(a, B, bar, MISC, ctl, lo, hi);
    layer_body<1>(a, B, bar, MISC, ctl, lo, hi);
#if DBG_TIMING
    xcd_barrier(bar); TSTAMP(2);
    if (B.bid == 0 && B.tid == 0) __hip_atomic_store(ctl + 20480, MISC[32 + DBG_TCLASS] / (unsigned)DBG_TUNIT, RLX_AGENT);
    xcd_barrier(bar);
    { const float addv = 0.1f * (float)__hip_atomic_load(ctl + 20480, RLX_AGENT); for (size_t i = (size_t)B.bid * 512 + B.tid; i < (size_t)M_LAT * D; i += (size_t)B.G * 512) a.out[i] += addv; }
#endif
#undef IN
#undef SEAM
}

extern "C" void kernel_launch(void* const* d_in, const int* in_sizes, int n_in, void* d_out, int out_size, void* d_ws, size_t ws_size, hipStream_t stream) {
    static int grid = 0;
    if (grid == 0) {
        if (n_in != N_IN || out_size != M_LAT * D || ws_size < WS_END) { fprintf(stderr, "kernel_launch: unexpected problem shape (n_in %d, out %d, ws %zu)\n", n_in, out_size, ws_size); grid = -1; return; }
        int dev = 0, cus = 0, per_cu = 0;
        if (hipGetDevice(&dev) != hipSuccess || hipDeviceGetAttribute(&cus, hipDeviceAttributeMultiprocessorCount, dev) != hipSuccess) { grid = -1; return; }
        if (hipFuncSetAttribute((const void*)fwd_kernel, hipFuncAttributeMaxDynamicSharedMemorySize, LDS_BYTES) != hipSuccess) { fprintf(stderr, "kernel_launch: hipFuncSetAttribute failed\n"); grid = -1; return; }
        if (hipOccupancyMaxActiveBlocksPerMultiprocessor(&per_cu, (const void*)fwd_kernel, NWAVES * 64, LDS_BYTES) != hipSuccess || per_cu < 1) fprintf(stderr, "kernel_launch: occupancy query reports %d\n", per_cu);
        (void)hipGetLastError();
        grid = cus;
    }
    if (grid < 0) return;
    if (hipMemsetAsync((char*)d_ws + WS_CTL, 0, CTL_BYTES, stream) != hipSuccess) return;
    Args a{};
    for (int i = 0; i < N_IN; ++i) a.in[i] = (const float*)d_in[i];
    a.out = (float*)d_out; a.ws = (unsigned char*)d_ws;
#if MK_MULTI
    for (int p = 0; p < N_PHASES; ++p) { if (p == 2 + PH_PER_LAYER + 6) continue; a.ph_lo = p; a.ph_hi = p + 1; hipLaunchKernelGGL(fwd_kernel, dim3(grid), dim3(NWAVES * 64), LDS_BYTES, stream, a);
#if DBG_CHECKS
        { Args c = a; c.ph_lo = 0; c.ph_hi = 0; int ids[2] = {0, 0};
          if (p == 0) ids[0] = 1; if (p == 2) ids[0] = 3; if (p == 3) ids[0] = 4; if (p == 4) ids[0] = 5; if (p == 5) ids[0] = 6; if (p == 7) ids[0] = 7; if (p == 8) ids[0] = 8; if (p == 9) ids[0] = 9;
          if (p == 20) { ids[0] = 13; ids[1] = 14; }
          for (int q = 0; q < 2; ++q) if (ids[q] && (DBG_CHECKS & (1 << ids[q]))) hipLaunchKernelGGL(chk_kernel, dim3((ids[q] == 8 || ids[q] == 14) ? 2 : 1), dim3(64), 0, stream, c, ids[q]); }
#endif
    }
#if DBG_CHECKS
    { Args c = a; c.ph_lo = 0; c.ph_hi = 0; hipLaunchKernelGGL(chk_apply, dim3(1024), dim3(256), 0, stream, c); }
#endif
#else
    a.ph_lo = 0; a.ph_hi = N_PHASES; hipLaunchKernelGGL(fwd_kernel, dim3(grid), dim3(NWAVES * 64), LDS_BYTES, stream, a);
#endif
}
```
